# Optimizing an MI355X kernel written in HIP

```python
import jax, jax.numpy as jnp
from jax import lax
import numpy as np

D_MODEL = 2048
BATCH = 4
SEQ = 2048
DEPTH = 1

CHUNK = 64
Q_BLOCK = 128
SB_HEADS = 8
SB_HEAD_DIM = 128
SB_WIDTH = SB_HEADS * SB_HEAD_DIM
MLA_HEADS = 8
MLA_NOPE_DIM = 128
MLA_ROPE_DIM = 64
MLA_V_DIM = 128
MLA_Q_RANK = 512
MLA_KV_RANK = 256
MLA_QK_DIM = MLA_NOPE_DIM + MLA_ROPE_DIM
MLA_WIDTH = MLA_HEADS * MLA_V_DIM
MIX_WIDTH = SB_WIDTH + MLA_WIDTH
IN_COLS = 3 * SB_WIDTH + MLA_Q_RANK + MLA_KV_RANK + MLA_ROPE_DIM
D_FF = 5632
CONV_WIDTH = 3
ROPE_THETA = 10000.0
EPS = 1e-6

kernel_name = "hymba_stickbreak_mla_convffn_block"


def rmsnorm(x, g):
    xf = x.astype(jnp.float32)
    y = xf * lax.rsqrt(jnp.mean(xf * xf, axis=-1, keepdims=True) + EPS)
    return (y * g.astype(jnp.float32)).astype(x.dtype)


def rope_tables(positions):
    half = MLA_ROPE_DIM // 2
    inv_freq = ROPE_THETA ** (-jnp.arange(half, dtype=jnp.float32) / half)
    ang = positions.astype(jnp.float32)[..., None] * inv_freq
    return jnp.cos(ang), jnp.sin(ang)


def apply_rope(x, cos, sin):
    x1, x2 = jnp.split(x.astype(jnp.float32), 2, axis=-1)
    return jnp.concatenate([x1 * cos - x2 * sin, x1 * sin + x2 * cos], axis=-1).astype(x.dtype)


def stick_breaking_attention(q, k, v):
    S, Dh = q.shape[1], q.shape[-1]
    scale = Dh ** -0.5
    outs = []
    for q0 in range(0, S, Q_BLOCK):
        q_end = q0 + Q_BLOCK
        z = jnp.einsum('bqhd,bkhd->bhqk', q[:, q0:q_end], k[:, :q_end]).astype(jnp.float32) * scale
        t = q0 + jnp.arange(Q_BLOCK)
        s = jnp.arange(q_end)
        mask = s[None, :] < t[:, None]
        log_1m = jnp.where(mask, -jax.nn.softplus(z), 0.0)
        after = lax.cumsum(log_1m, axis=3, reverse=True) - log_1m
        a = jnp.where(mask, jnp.exp(jax.nn.log_sigmoid(z) + after), 0.0)
        outs.append(jnp.einsum('bhqk,bkhd->bqhd', a.astype(v.dtype), v[:, :q_end]))
    return jnp.concatenate(outs, axis=1)


def mla_attention(q_nope, q_rope, k_nope, k_rope, v):
    S = q_nope.shape[1]
    scale = MLA_QK_DIM ** -0.5
    outs = []
    for q0 in range(0, S, Q_BLOCK):
        q_end = q0 + Q_BLOCK
        s_nope = jnp.einsum('bqhd,bkhd->bhqk', q_nope[:, q0:q_end], k_nope[:, :q_end])
        s_rope = jnp.einsum('bqhd,bkd->bhqk', q_rope[:, q0:q_end], k_rope[:, :q_end])
        scores = (s_nope.astype(jnp.float32) + s_rope.astype(jnp.float32)) * scale
        t_chunk = (q0 + jnp.arange(Q_BLOCK)) // CHUNK
        s_chunk = jnp.arange(q_end) // CHUNK
        mask = s_chunk[None, :] <= t_chunk[:, None]
        p = jax.nn.softmax(jnp.where(mask, scores, -jnp.inf), axis=-1)
        outs.append(jnp.einsum('bhqk,bkhd->bqhd', p.astype(v.dtype), v[:, :q_end]))
    return jnp.concatenate(outs, axis=1)


def causal_depthwise_conv(u, w, b):
    S = u.shape[1]
    up = jnp.pad(u, ((0, 0), (CONV_WIDTH - 1, 0), (0, 0)))
    y = up[:, 0:S] * w[0]
    for j in range(1, CONV_WIDTH):
        y = y + up[:, j:j + S] * w[j]
    return y + b


def setup_inputs(seed: int = 0) -> dict:
    key = jax.random.key(seed)
    ks = jax.random.split(key, 20)
    f32 = jnp.float32
    L = DEPTH

    def wt(k, shape, fan_in):
        return jax.random.normal(k, shape, f32) * fan_in ** -0.5

    def gain(k, shape):
        return 1.0 + 0.02 * jax.random.normal(k, shape, f32)

    x = jax.random.normal(ks[0], (BATCH, SEQ, D_MODEL), f32)
    positions = jnp.tile(jnp.arange(SEQ, dtype=jnp.int32)[None, :], (BATCH, 1))
    return {
        "x": x,
        "positions": positions,
        "g_attn_pre": gain(ks[1], (L, D_MODEL)),
        "w_in": wt(ks[2], (L, D_MODEL, IN_COLS), D_MODEL),
        "g_cq": gain(ks[3], (L, MLA_Q_RANK)),
        "w_uq": wt(ks[4], (L, MLA_Q_RANK, MLA_HEADS * MLA_QK_DIM), MLA_Q_RANK),
        "g_ckv": gain(ks[5], (L, MLA_KV_RANK)),
        "w_ukv": wt(ks[6], (L, MLA_KV_RANK, MLA_HEADS * (MLA_NOPE_DIM + MLA_V_DIM)), MLA_KV_RANK),
        "g_out_sb": gain(ks[7], (L, SB_WIDTH)),
        "g_out_mla": gain(ks[8], (L, MLA_WIDTH)),
        "w_o": wt(ks[9], (L, MIX_WIDTH, D_MODEL), MIX_WIDTH),
        "g_attn_post": gain(ks[10], (L, D_MODEL)),
        "g_ffn_pre": gain(ks[11], (L, D_MODEL)),
        "w_up": wt(ks[12], (L, D_MODEL, 2 * D_FF), D_MODEL),
        "conv_w": wt(ks[13], (L, CONV_WIDTH, 2 * D_FF), CONV_WIDTH),
        "conv_b": 0.02 * jax.random.normal(ks[14], (L, 2 * D_FF), f32),
        "w_down": wt(ks[15], (L, D_FF, D_MODEL), D_FF),
        "g_ffn_post": gain(ks[16], (L, D_MODEL)),
    }


def reference(x, positions, g_attn_pre, w_in, g_cq, w_uq, g_ckv, w_ukv, g_out_sb, g_out_mla,
              w_o, g_attn_post, g_ffn_pre, w_up, conv_w, conv_b, w_down, g_ffn_post):
    B, S, _ = x.shape
    cos, sin = rope_tables(positions)
    split_points = np.cumsum([SB_WIDTH, SB_WIDTH, SB_WIDTH, MLA_Q_RANK, MLA_KV_RANK])
    split_points = split_points.tolist()
    for l in range(DEPTH):
        h = rmsnorm(x, g_attn_pre[l])
        proj = h @ w_in[l]
        q_sb, k_sb, v_sb, c_q, c_kv, k_rope = jnp.split(proj, split_points, axis=-1)

        o_sb = stick_breaking_attention(
            q_sb.reshape(B, S, SB_HEADS, SB_HEAD_DIM),
            k_sb.reshape(B, S, SB_HEADS, SB_HEAD_DIM),
            v_sb.reshape(B, S, SB_HEADS, SB_HEAD_DIM)).reshape(B, S, SB_WIDTH)

        q = (rmsnorm(c_q, g_cq[l]) @ w_uq[l]).reshape(B, S, MLA_HEADS, MLA_QK_DIM)
        q_nope, q_rope = jnp.split(q, [MLA_NOPE_DIM], axis=-1)
        q_rope = apply_rope(q_rope, cos[:, :, None, :], sin[:, :, None, :])
        kv = (rmsnorm(c_kv, g_ckv[l]) @ w_ukv[l]).reshape(B, S, MLA_HEADS, MLA_NOPE_DIM + MLA_V_DIM)
        k_nope, v_mla = jnp.split(kv, [MLA_NOPE_DIM], axis=-1)
        k_rope = apply_rope(k_rope, cos, sin)
        o_mla = mla_attention(q_nope, q_rope, k_nope, k_rope, v_mla).reshape(B, S, MLA_WIDTH)

        mixed = jnp.concatenate([rmsnorm(o_sb, g_out_sb[l]), rmsnorm(o_mla, g_out_mla[l])], axis=-1)
        x = x + rmsnorm(mixed @ w_o[l], g_attn_post[l])

        h = rmsnorm(x, g_ffn_pre[l])
        u = causal_depthwise_conv(h @ w_up[l], conv_w[l], conv_b[l])
        gate, val = jnp.split(u, 2, axis=-1)
        y = (jax.nn.gelu(gate, approximate=True) * val) @ w_down[l]
        x = x + rmsnorm(y, g_ffn_post[l])
    return x
```

```cpp
#include <hip/hip_runtime.h>
#include <hip/hip_bf16.h>
#include <hip/hip_cooperative_groups.h>
#include <cstdio>
#include <cstdint>
namespace cg = cooperative_groups;

typedef unsigned short bf16_t;
using bf16x8 = __attribute__((ext_vector_type(8))) short;
using s16x4  = __attribute__((ext_vector_type(4))) short;
using f32x4  = __attribute__((ext_vector_type(4))) float;
using f32x16 = __attribute__((ext_vector_type(16))) float;
using u32x4  = __attribute__((ext_vector_type(4))) unsigned;
using u32x2  = __attribute__((ext_vector_type(2))) unsigned;
using i32x4  = __attribute__((ext_vector_type(4))) int;
#define DEV __device__ __forceinline__
#define LDS_AS __attribute__((address_space(3)))
#define SBAR() __builtin_amdgcn_sched_barrier(0)

constexpr int T_ = 8192, DM = 2048, SEQ = 2048;
constexpr int INC = 3904, INP = 4096, DFF = 5632, DFF2 = 11264;
constexpr float EPS = 1e-6f;
#ifndef PHASES
#define PHASES 0x3ff
#endif
#define PH(k) if constexpr ((PHASES >> (k)) & 1)
constexpr size_t MiB = 1024 * 1024;
constexpr size_t OFF_WIN = 0, OFF_WUQ = 16 * MiB, OFF_WUKV = OFF_WUQ + 3 * MiB / 2, OFF_WO = OFF_WUKV + MiB, OFF_H = OFF_WO + 8 * MiB,
                 OFF_Y = OFF_H + 32 * MiB, OFF_ACT = 0, OFF_WUP = OFF_Y + 32 * MiB, OFF_WDN = OFF_WUP + 44 * MiB, OFF_UP = OFF_WDN + 22 * MiB,
                 OFF_PROJ = OFF_UP, OFF_Q = OFF_UP + 64 * MiB, OFF_KV = OFF_Q + 24 * MiB, OFF_O = OFF_KV + 32 * MiB, OFF_Y2 = OFF_UP,
                 OFF_COS = OFF_UP + 176 * MiB, OFF_SIN = OFF_COS + MiB, OFF_STC = OFF_SIN + MiB, OFF_STO = OFF_STC + MiB / 2,
                 OFF_STY = OFF_STO + MiB / 2, OFF_STY2 = OFF_STY + MiB, OFF_CNT = OFF_STY2 + MiB, WS_END = OFF_CNT + 256;

struct Params {
  const float* x; const int* pos; const float* g_attn_pre; const float* w_in; const float* g_cq; const float* w_uq; const float* g_ckv; const float* w_ukv;
  const float* g_out_sb; const float* g_out_mla; const float* w_o; const float* g_attn_post; const float* g_ffn_pre; const float* w_up; const float* conv_w;
  const float* conv_b; const float* w_down; const float* g_ffn_post; float* out; char* ws;
};

DEV unsigned cvtpk(float lo, float hi) { unsigned r; asm volatile("v_cvt_pk_bf16_f32 %0, %1, %2" : "=v"(r) : "v"(lo), "v"(hi)); return r; }
DEV float bf_lo(unsigned w) { return __uint_as_float(w << 16); }
DEV float bf_hi(unsigned w) { return __uint_as_float(w & 0xffff0000u); }
DEV int crow(int r, int hi) { return (r & 3) + 8 * (r >> 2) + 4 * hi; }
DEV int opaque_tid() { int t = threadIdx.x; asm volatile("" : "+v"(t)); return t; }
DEV float wave_sum(float s) {
  s += __shfl_xor(s, 32); s += __shfl_xor(s, 16); s += __shfl_xor(s, 8); s += __shfl_xor(s, 4); s += __shfl_xor(s, 2); s += __shfl_xor(s, 1); return s;
}

DEV const char* uptr(const void* p) {
  const unsigned long long v = (unsigned long long)p;
  const unsigned lo = __builtin_amdgcn_readfirstlane((unsigned)v), hi = __builtin_amdgcn_readfirstlane((unsigned)(v >> 32));
  return (const char*)(((unsigned long long)hi << 32) | lo);
}
DEV int lds_byte2(int r, int c) { int st = (r >> 4) * 2 + (c >> 5), ob = (r & 15) * 64 + (c & 31) * 2; return st * 1024 + (ob ^ (((ob >> 9) & 1) << 5)); }
DEV void stage_rc2(int b, int& R, int& C) { int st = b >> 10, sb = b & 1023, swz = sb ^ (((sb >> 9) & 1) << 5); R = (st >> 1) * 16 + swz / 64; C = (st & 1) * 32 + (swz % 64) / 2; }

template <int MODE> struct Epi {
  bf16_t* out; int ldo; const float* st_in; float* st_out; const float* cosT; const float* sinT;
  DEV void hook(f32x4 (&acc)[8][4], int rbase, int fr) const {
#pragma unroll
    for (int m = 0; m < 8; ++m) {
      const int row = rbase + m * 16 + fr; const float* sp = st_in + (size_t)row * 16;
      const f32x4 a0 = *(const f32x4*)(sp), a1 = *(const f32x4*)(sp + 4), b0 = *(const f32x4*)(sp + 8), b1 = *(const f32x4*)(sp + 12);
      const float ssb = (a0[0] + a0[1]) + (a0[2] + a0[3]) + (a1[0] + a1[1]) + (a1[2] + a1[3]);
      const float sml = (b0[0] + b0[1]) + (b0[2] + b0[3]) + (b1[0] + b1[1]) + (b1[2] + b1[3]);
      const float ratio = rsqrtf(ssb * (1.f / 1024.f) + EPS) / rsqrtf(sml * (1.f / 1024.f) + EPS);
#pragma unroll
      for (int n = 0; n < 4; ++n) acc[m][n] *= ratio;
      asm volatile("" ::: "memory");
    }
  }
  DEV void operator()(const f32x4 (&acc)[8][4], int rbase, int cbase, int fr, int fq) const {
    const bool do_rope = MODE == 0 ? (cbase == 3840) : (MODE == 1 ? ((cbase % 192) == 128) : false);
    const bool do_stat = MODE == 0 ? (cbase >= 3072 && cbase < 3840) : (MODE == 3 || MODE == 5);
    const int slot = MODE == 0 ? ((cbase - 3072) >> 6) : (cbase >> 6);
    constexpr int SS = MODE == 0 ? 16 : 32;
#pragma unroll
    for (int m = 0; m < 8; ++m) {
      const int row = rbase + m * 16 + fr;
      float rs = 1.f;
      if (MODE == 1) { const float* sp = st_in + (size_t)row * 16; const f32x4 a0 = *(const f32x4*)(sp), a1 = *(const f32x4*)(sp + 4);
        rs = rsqrtf(((a0[0] + a0[1]) + (a0[2] + a0[3]) + (a1[0] + a1[1]) + (a1[2] + a1[3])) * (1.f / 512.f) + EPS); }
      if (MODE == 2) { const f32x4 a0 = *(const f32x4*)(st_in + (size_t)row * 16 + 8); rs = rsqrtf(((a0[0] + a0[1]) + (a0[2] + a0[3])) * (1.f / 256.f) + EPS); }
      if (MODE == 3) { const float* sp = st_in + (size_t)row * 16 + 8; const f32x4 a0 = *(const f32x4*)(sp), a1 = *(const f32x4*)(sp + 4);
        rs = rsqrtf(((a0[0] + a0[1]) + (a0[2] + a0[3]) + (a1[0] + a1[1]) + (a1[2] + a1[3])) * (1.f / 1024.f) + EPS); }
      f32x4 v[4];
#pragma unroll
      for (int n = 0; n < 4; ++n) v[n] = acc[m][n] * rs;
      if (MODE <= 1) {
        if (do_rope) {
          const f32x4 c0 = *(const f32x4*)(cosT + (size_t)row * 32 + fq * 4), c1 = *(const f32x4*)(cosT + (size_t)row * 32 + 16 + fq * 4);
          const f32x4 s0 = *(const f32x4*)(sinT + (size_t)row * 32 + fq * 4), s1 = *(const f32x4*)(sinT + (size_t)row * 32 + 16 + fq * 4);
          const f32x4 x1a = v[0], x2a = v[2], x1b = v[1], x2b = v[3];
          v[0] = x1a * c0 - x2a * s0; v[2] = x1a * s0 + x2a * c0; v[1] = x1b * c1 - x2b * s1; v[3] = x1b * s1 + x2b * c1;
        }
      }
      if (MODE == 0 || MODE == 3 || MODE == 5) {
        if (do_stat) {
          float s = 0.f;
#pragma unroll
          for (int n = 0; n < 4; ++n) s += (v[n][0] * v[n][0] + v[n][1] * v[n][1]) + (v[n][2] * v[n][2] + v[n][3] * v[n][3]);
          s += __shfl_xor(s, 16); s += __shfl_xor(s, 32);
          *(float*)((char*)uptr(st_out) + (unsigned)(row * SS + slot) * 4u) = s;
        }
      }
      char* ob = (char*)uptr(out); const unsigned oo = (unsigned)(row * ldo + cbase + fq * 4) * 2u;
#pragma unroll
      for (int n = 0; n < 4; ++n) { u32x2 w; w[0] = cvtpk(v[n][0], v[n][1]); w[1] = cvtpk(v[n][2], v[n][3]); *(u32x2*)(ob + oo + n * 32) = w; }
      asm volatile("" ::: "memory");
    }
  }
};

template <int MODE>
DEV void gemm_phase(char* shm, const bf16_t* __restrict__ A, int lda, const bf16_t* __restrict__ Bt, int K, int nN, const Epi<MODE>& epi) {
  constexpr int TILE_B = 32768, STAGE_B = 65536;
  const int tid = opaque_tid(), wid = tid >> 6, lane = tid & 63, wr = wid >> 2, wc = wid & 3, fr = lane & 15, fq = lane >> 4;
  unsigned oA[4], oB[4];
#pragma unroll
  for (int i = 0; i < 4; ++i) { int R, C; stage_rc2(wid * 1024 + i * 8192 + lane * 16, R, C); oA[i] = (unsigned)(R * lda + C) * 2u; oB[i] = (unsigned)(R * K + C) * 2u; }
  const int nt = K >> 6, nUnits = 32 * nN;
  LDS_AS char* lshm = (LDS_AS char*)shm;
#define G_SA(b) (shm + (b) * STAGE_B)
#define G_SB(b) (shm + (b) * STAGE_B + TILE_B)
#define G_STAGE(buf, kt) do { const char* a_ = uptr(Ab + (kt) * 64); const char* b_ = uptr(Bb + (kt) * 64); _Pragma("unroll") for (int i = 0; i < 4; ++i) { \
      __builtin_amdgcn_global_load_lds((const unsigned*)(a_ + oA[i]), (LDS_AS unsigned*)(lshm + (buf) * STAGE_B + wid * 1024 + i * 8192), 16, 0, 0); \
      __builtin_amdgcn_global_load_lds((const unsigned*)(b_ + oB[i]), (LDS_AS unsigned*)(lshm + (buf) * STAGE_B + TILE_B + wid * 1024 + i * 8192), 16, 0, 0); } } while (0)
#define G_KSTEP(buf, ks) do { bf16x8 At[8], Bf[4]; \
      _Pragma("unroll") for (int m = 0; m < 8; ++m) At[m] = *(const bf16x8*)(G_SA(buf) + lds_byte2(wr * 128 + m * 16 + fr, (ks) * 32 + fq * 8)); \
      _Pragma("unroll") for (int n = 0; n < 4; ++n) Bf[n] = *(const bf16x8*)(G_SB(buf) + lds_byte2(wc * 64 + n * 16 + fr, (ks) * 32 + fq * 8)); \
      _Pragma("unroll") for (int m = 0; m < 8; ++m) _Pragma("unroll") for (int n = 0; n < 4; ++n) \
        acc[m][n] = __builtin_amdgcn_mfma_f32_16x16x32_bf16(Bf[n], At[m], acc[m][n], 0, 0, 0); SBAR(); } while (0)
  for (int u = blockIdx.x; u < nUnits; u += gridDim.x) {
    const int pm = (u & 15) + 16 * (u / (16 * nN)), pn = (u >> 4) % nN;
    const bf16_t* Ab = A + (size_t)pm * 256 * lda; const bf16_t* Bb = Bt + (size_t)pn * 256 * K;
    f32x4 acc[8][4];
#pragma unroll
    for (int m = 0; m < 8; ++m)
#pragma unroll
      for (int n = 0; n < 4; ++n) acc[m][n] = (f32x4){0.f, 0.f, 0.f, 0.f};
    G_STAGE(0, 0); asm volatile("s_waitcnt vmcnt(0)" ::: "memory"); __syncthreads();
    for (int t = 0; t < nt; ++t) {
      const int cur = t & 1;
      if (t + 1 < nt) G_STAGE(cur ^ 1, t + 1);
      if (MODE == 3) { if (t == 16) { const int t2 = opaque_tid(); epi.hook(acc, pm * 256 + ((t2 >> 8) & 1) * 128, t2 & 15); } }
      G_KSTEP(cur, 0); G_KSTEP(cur, 1);
      asm volatile("s_waitcnt vmcnt(0)" ::: "memory"); __syncthreads();
    }
    { const int t2 = opaque_tid(); epi(acc, pm * 256 + ((t2 >> 8) & 1) * 128, pn * 256 + ((t2 >> 6) & 3) * 64, t2 & 15, (t2 >> 4) & 3); }
  }
#undef G_SA
#undef G_SB
#undef G_STAGE
#undef G_KSTEP
}

DEV int v_st(int k, int c) { const int kk = (k & ~0xC) | ((k & 4) << 1) | ((k & 8) >> 1); return ((kk >> 3) * 4 + (c >> 5)) * 512 + ((kk & 7) * 32 + (c & 31)) * 2; }
DEV int v_rd_base(int lane) { return ((lane & 3) << 3) | (((lane >> 2) & 3) << 6) | (((lane >> 4) & 1) << 5) | (((lane >> 5) & 1) << 8); }
constexpr int v_rd_off(int d0, int ks, int half) { return d0 * 512 + ks * 4096 + half * 2048; }
template <int OFF> DEV s16x4 tr_read(int vb) { s16x4 r; asm volatile("ds_read_b64_tr_b16 %0, %1 offset:%2" : "=&v"(r) : "v"(vb), "i"(OFF) : "memory"); return r; }
template <int D0> DEV void pv_one(f32x16& od, int vb, bf16x8 pa0, bf16x8 pa1, bf16x8 pa2, bf16x8 pa3) {
  const s16x4 l0 = tr_read<v_rd_off(D0, 0, 0)>(vb), h0 = tr_read<v_rd_off(D0, 0, 1)>(vb), l1 = tr_read<v_rd_off(D0, 1, 0)>(vb), h1 = tr_read<v_rd_off(D0, 1, 1)>(vb);
  const s16x4 l2 = tr_read<v_rd_off(D0, 2, 0)>(vb), h2 = tr_read<v_rd_off(D0, 2, 1)>(vb), l3 = tr_read<v_rd_off(D0, 3, 0)>(vb), h3 = tr_read<v_rd_off(D0, 3, 1)>(vb);
  asm volatile("s_waitcnt lgkmcnt(0)" ::: "memory"); SBAR();
#define PKV(L, H) (bf16x8){L[0], L[1], L[2], L[3], H[0], H[1], H[2], H[3]}
  od = __builtin_amdgcn_mfma_f32_32x32x16_bf16(pa0, PKV(l0, h0), od, 0, 0, 0);
  od = __builtin_amdgcn_mfma_f32_32x32x16_bf16(pa1, PKV(l1, h1), od, 0, 0, 0);
  od = __builtin_amdgcn_mfma_f32_32x32x16_bf16(pa2, PKV(l2, h2), od, 0, 0, 0);
  od = __builtin_amdgcn_mfma_f32_32x32x16_bf16(pa3, PKV(l3, h3), od, 0, 0, 0);
#undef PKV
}
#define PK4(P, BASE, OUT) do { unsigned a0_ = cvtpk(P[BASE + 0], P[BASE + 1]), a1_ = cvtpk(P[BASE + 2], P[BASE + 3]);   \
    unsigned b0_ = cvtpk(P[BASE + 4], P[BASE + 5]), b1_ = cvtpk(P[BASE + 6], P[BASE + 7]);                              \
    auto r0_ = __builtin_amdgcn_permlane32_swap(a0_, b0_, false, false); auto r1_ = __builtin_amdgcn_permlane32_swap(a1_, b1_, false, false); \
    u32x4 w_ = {r0_[0], r1_[0], r0_[1], r1_[1]}; OUT = *reinterpret_cast<bf16x8*>(&w_); } while (0)

DEV void sb_half(f32x16& P, float& run, bool diag, int key0, int qrow, int hi) {
  constexpr float C = 0.08838834764831845f * 1.4426950408889634f;
#pragma unroll
  for (int r = 0; r < 16; ++r) P[r] *= C;
  if (diag) {
#pragma unroll
    for (int r = 0; r < 16; ++r) { if (key0 + crow(r, hi) >= qrow) P[r] = -1e30f; }
  }
  f32x16 L;
#pragma unroll
  for (int r = 0; r < 16; ++r) L[r] = -(fmaxf(P[r], 0.f) + __builtin_amdgcn_logf(1.f + __builtin_amdgcn_exp2f(-fabsf(P[r]))));
#pragma unroll
  for (int g = 3; g >= 0; --g) {
    const float gs = (L[4 * g] + L[4 * g + 1]) + (L[4 * g + 2] + L[4 * g + 3]);
    auto rr = __builtin_amdgcn_permlane32_swap(__float_as_uint(gs), __float_as_uint(gs), false, false);
    const float lo = __uint_as_float(rr[0]), hv = __uint_as_float(rr[1]);
    const float e3 = run + (hi == 0 ? hv : 0.f), e2 = e3 + L[4 * g + 3], e1 = e2 + L[4 * g + 2], e0 = e1 + L[4 * g + 1];
    run += lo + hv;
    P[4 * g + 3] = __builtin_amdgcn_exp2f(P[4 * g + 3] + L[4 * g + 3] + e3); P[4 * g + 2] = __builtin_amdgcn_exp2f(P[4 * g + 2] + L[4 * g + 2] + e2);
    P[4 * g + 1] = __builtin_amdgcn_exp2f(P[4 * g + 1] + L[4 * g + 1] + e1); P[4 * g + 0] = __builtin_amdgcn_exp2f(P[4 * g + 0] + L[4 * g + 0] + e0);
  }
}
DEV void sb_tile(f32x16& p0, f32x16& p1, float& carry, bool diag, int kt0, int qrow, int hi) {
  sb_half(p1, carry, diag, kt0 + 32, qrow, hi);
  sb_half(p0, carry, diag, kt0, qrow, hi);
}

template <bool MLA>
DEV void attn_unit(char* lds, const bf16_t* __restrict__ Qb, int ldq, const bf16_t* __restrict__ Kb, int ldk, const bf16_t* __restrict__ Krb, int ldkr,
                   const bf16_t* __restrict__ Vb, int ldv, bf16_t* __restrict__ Ob, int ldo, float* __restrict__ statb, int qb) {
  constexpr int DQ = MLA ? 192 : 128, ND = DQ / 16, ROWB = DQ * 2, SHMK = 64 * ROWB, SHMV = 16384, BUF = SHMK + SHMV;
#define KSWZ(row, colB) ((row) * ROWB + ((colB) ^ (((row) & 7) << 4)))
  const int tid = opaque_tid(), wid = tid >> 6, lane = tid & 63, r32 = lane & 31, hi = lane >> 5;
  float* al_l = (float*)(lds + 2 * BUF + wid * 256); float* li_l = al_l + 32;
  const int q0w = 256 * qb + 32 * wid, qrow = q0w + r32;
  bf16x8 qr[ND];
  { const bf16_t* Qw = Qb + (size_t)qrow * ldq + hi * 8;
#pragma unroll
    for (int d0 = 0; d0 < ND; ++d0) qr[d0] = *(const bf16x8*)(Qw + d0 * 16); }
  f32x16 o[4];
#pragma unroll
  for (int d = 0; d < 4; ++d)
#pragma unroll
    for (int r = 0; r < 16; ++r) o[d][r] = 0.f;
  float carry = 0.f, m_reg = -1e30f, l_reg = 0.f;
  const int NT = 4 * qb + 4, jmax = 4 * qb + (wid >> 1);
  const int sr = tid >> 4, sc = (tid & 15) * 8, vst0 = v_st(sr, sc), vst1 = v_st(32 + sr, sc), krr = tid >> 3, krc = (tid & 7) * 8;
  const int vb0 = (int)(unsigned)(uintptr_t)(lds + SHMK) + v_rd_base(lane);
  bf16x8 ks0, ks1, vs0, vs1, kx;
#define A_LOAD(jt) do { const int kt0_ = (jt) * 64; \
    ks0 = *(const bf16x8*)(Kb + (size_t)(kt0_ + sr) * ldk + sc); ks1 = *(const bf16x8*)(Kb + (size_t)(kt0_ + 32 + sr) * ldk + sc); \
    vs0 = *(const bf16x8*)(Vb + (size_t)(kt0_ + sr) * ldv + sc); vs1 = *(const bf16x8*)(Vb + (size_t)(kt0_ + 32 + sr) * ldv + sc); \
    if (MLA) kx = *(const bf16x8*)(Krb + (size_t)(kt0_ + krr) * ldkr + krc); SBAR(); } while (0)
#define A_WRITE(b) do { char* base_ = lds + (b) * BUF; \
    *(bf16x8*)(base_ + KSWZ(sr, sc * 2)) = ks0; *(bf16x8*)(base_ + KSWZ(32 + sr, sc * 2)) = ks1; \
    *(bf16x8*)(base_ + SHMK + vst0) = vs0; *(bf16x8*)(base_ + SHMK + vst1) = vs1; \
    if (MLA) *(bf16x8*)(base_ + KSWZ(krr, (128 + krc) * 2)) = kx; } while (0)
  A_LOAD(NT - 1); A_WRITE(0); A_LOAD(NT - 2); __syncthreads();
  for (int i = 0; i < NT; ++i) {
    const int jt = NT - 1 - i, cur = i & 1;
    if (i + 1 < NT) A_WRITE(cur ^ 1);
    if (i + 2 < NT) A_LOAD(jt - 2);
    if (jt <= jmax) {
      const char* Kl = lds + cur * BUF;
      f32x16 p0, p1;
#pragma unroll
      for (int r = 0; r < 16; ++r) { p0[r] = 0.f; p1[r] = 0.f; }
#pragma unroll
      for (int d0 = 0; d0 < ND; ++d0) {
        const int cb = (d0 * 16 + hi * 8) * 2;
        const bf16x8 b0 = *(const bf16x8*)(Kl + KSWZ(r32, cb));
        const bf16x8 b1 = *(const bf16x8*)(Kl + KSWZ(32 + r32, cb));
        p0 = __builtin_amdgcn_mfma_f32_32x32x16_bf16(b0, qr[d0], p0, 0, 0, 0);
        p1 = __builtin_amdgcn_mfma_f32_32x32x16_bf16(b1, qr[d0], p1, 0, 0, 0);
      }
      if (MLA) {
        constexpr float C2 = 0.07216878364870323f * 1.4426950408889634f;
        float pmax = p0[0];
#pragma unroll
        for (int r = 1; r < 16; ++r) pmax = fmaxf(pmax, p0[r]);
#pragma unroll
        for (int r = 0; r < 16; ++r) pmax = fmaxf(pmax, p1[r]);
        { auto rr = __builtin_amdgcn_permlane32_swap(__float_as_uint(pmax), __float_as_uint(pmax), false, false);
          pmax = fmaxf(__uint_as_float(rr[0]), __uint_as_float(rr[1])); }
        const float mn = fmaxf(m_reg, pmax), alpha = __builtin_amdgcn_exp2f((m_reg - mn) * C2); m_reg = mn;
        const float mnC = -mn * C2;
        float ps = 0.f;
#pragma unroll
        for (int r = 0; r < 16; ++r) { p0[r] = __builtin_amdgcn_exp2f(fmaf(p0[r], C2, mnC)); p1[r] = __builtin_amdgcn_exp2f(fmaf(p1[r], C2, mnC)); ps += p0[r] + p1[r]; }
        { auto rr = __builtin_amdgcn_permlane32_swap(__float_as_uint(ps), __float_as_uint(ps), false, false);
          ps = __uint_as_float(rr[0]) + __uint_as_float(rr[1]); }
        l_reg = l_reg * alpha + ps;
        if (__any(alpha < 1.f)) {
          if (hi == 0) al_l[r32] = alpha;
          asm volatile("s_waitcnt lgkmcnt(0)" ::: "memory");
#pragma unroll
          for (int r = 0; r < 16; ++r) { const float a = al_l[crow(r, hi)];
#pragma unroll
            for (int d = 0; d < 4; ++d) o[d][r] *= a; }
        }
      } else {
        sb_tile(p0, p1, carry, jt == jmax, jt * 64, qrow, hi);
      }
      bf16x8 pa0, pa1, pa2, pa3;
      PK4(p0, 0, pa0); PK4(p0, 8, pa1); PK4(p1, 0, pa2); PK4(p1, 8, pa3);
      const int vb = vb0 + cur * BUF;
      pv_one<0>(o[0], vb, pa0, pa1, pa2, pa3); pv_one<1>(o[1], vb, pa0, pa1, pa2, pa3); pv_one<2>(o[2], vb, pa0, pa1, pa2, pa3); pv_one<3>(o[3], vb, pa0, pa1, pa2, pa3);
    }
    __syncthreads();
  }
  if (MLA) {
    if (hi == 0) li_l[r32] = l_reg;
    asm volatile("s_waitcnt lgkmcnt(0)" ::: "memory");
#pragma unroll
    for (int r = 0; r < 16; ++r) { const float rl = 1.f / li_l[crow(r, hi)];
#pragma unroll
      for (int d = 0; d < 4; ++d) o[d][r] *= rl; }
  }
#pragma unroll
  for (int r = 0; r < 16; ++r) {
    const int orow = q0w + crow(r, hi);
    float s = (o[0][r] * o[0][r] + o[1][r] * o[1][r]) + (o[2][r] * o[2][r] + o[3][r] * o[3][r]);
    s += __shfl_xor(s, 16); s += __shfl_xor(s, 8); s += __shfl_xor(s, 4); s += __shfl_xor(s, 2); s += __shfl_xor(s, 1);
    if (r32 == 0) statb[(size_t)orow * 16] = s;
#pragma unroll
    for (int d = 0; d < 4; ++d) Ob[(size_t)orow * ldo + d * 32 + r32] = (bf16_t)(cvtpk(o[d][r], o[d][r]) & 0xffffu);
  }
#undef A_LOAD
#undef A_WRITE
#undef KSWZ
}

DEV void transpose_tile(char* shm, const float* __restrict__ src, bf16_t* __restrict__ dst, const float* __restrict__ g, int K, int N, int kt, int ntile) {
  float* tile = (float*)shm;
  const int tid = opaque_tid(), k0 = kt * 64, n0 = ntile * 256, n4 = (tid & 63) * 4, kr = tid >> 6;
#pragma unroll
  for (int i = 0; i < 8; ++i) {
    const int k = kr + 8 * i; f32x4 v = {0.f, 0.f, 0.f, 0.f};
    if (n0 + n4 < N) v = *(const f32x4*)(src + (size_t)(k0 + k) * N + n0 + n4);
    if (g) v *= g[k0 + k];
    tile[k * 257 + n4 + 0] = v[0]; tile[k * 257 + n4 + 1] = v[1]; tile[k * 257 + n4 + 2] = v[2]; tile[k * 257 + n4 + 3] = v[3];
  }
  __syncthreads();
  const int n = tid >> 1, kh = (tid & 1) * 32;
#pragma unroll
  for (int q = 0; q < 4; ++q) {
    u32x4 w;
#pragma unroll
    for (int j = 0; j < 4; ++j) w[j] = cvtpk(tile[(kh + 8 * q + 2 * j) * 257 + n], tile[(kh + 8 * q + 2 * j + 1) * 257 + n]);
    *(u32x4*)(dst + (size_t)(n0 + n) * K + k0 + kh + 8 * q) = w;
  }
  __syncthreads();
}

DEV float gelu_tanh(float x) {
  const float u = x + 0.044715f * x * x * x;
  return x * __builtin_amdgcn_rcpf(1.f + __builtin_amdgcn_exp2f(-2.302208198f * u));
}

__global__ void __launch_bounds__(512, 2) fwd_kernel(Params p) {
  __shared__ __attribute__((aligned(1024))) char shm[131072];
  __shared__ int s_unit;
  cg::grid_group grid = cg::this_grid();
  const int bid = blockIdx.x, nblk = gridDim.x;
  char* ws = p.ws;
  bf16_t* WIN = (bf16_t*)(ws + OFF_WIN); bf16_t* WUQ = (bf16_t*)(ws + OFF_WUQ); bf16_t* WUKV = (bf16_t*)(ws + OFF_WUKV); bf16_t* WO = (bf16_t*)(ws + OFF_WO);
  bf16_t* H = (bf16_t*)(ws + OFF_H); bf16_t* Y = (bf16_t*)(ws + OFF_Y); bf16_t* ACT = (bf16_t*)(ws + OFF_ACT); bf16_t* WUP = (bf16_t*)(ws + OFF_WUP);
  bf16_t* WDN = (bf16_t*)(ws + OFF_WDN); bf16_t* UP = (bf16_t*)(ws + OFF_UP); bf16_t* PROJ = (bf16_t*)(ws + OFF_PROJ); bf16_t* Q = (bf16_t*)(ws + OFF_Q);
  bf16_t* KV = (bf16_t*)(ws + OFF_KV); bf16_t* O = (bf16_t*)(ws + OFF_O); bf16_t* Y2 = (bf16_t*)(ws + OFF_Y2);
  float* COS = (float*)(ws + OFF_COS); float* SIN = (float*)(ws + OFF_SIN); float* STC = (float*)(ws + OFF_STC); float* STO = (float*)(ws + OFF_STO);
  float* STY = (float*)(ws + OFF_STY); float* STY2 = (float*)(ws + OFF_STY2); unsigned* CNT = (unsigned*)(ws + OFF_CNT);

  PH(0) {
    const int tid = opaque_tid(), wid = tid >> 6, lane = tid & 63;
    if (bid == 0 && tid == 0) *CNT = 0u;
    for (int ti = bid; ti < 2960; ti += nblk) {
      const float* src; bf16_t* dst; const float* g = nullptr; int K, N, ntn, loc;
      if (ti < 512) { src = p.w_in; dst = WIN; K = 2048; N = INC; ntn = 16; loc = ti; }
      else if (ti < 560) { src = p.w_uq; dst = WUQ; g = p.g_cq; K = 512; N = 1536; ntn = 6; loc = ti - 512; }
      else if (ti < 592) { src = p.w_ukv; dst = WUKV; g = p.g_ckv; K = 256; N = 2048; ntn = 8; loc = ti - 560; }
      else if (ti < 848) { src = p.w_o; dst = WO; K = 2048; N = 2048; ntn = 8; loc = ti - 592; }
      else if (ti < 2256) { src = p.w_up; dst = WUP; K = 2048; N = DFF2; ntn = 44; loc = ti - 848; }
      else { src = p.w_down; dst = WDN; K = DFF; N = 2048; ntn = 8; loc = ti - 2256; }
      const int kt = loc / ntn, ntile = loc % ntn;
      if (ti >= 592 && ti < 848) g = (kt < 16) ? p.g_out_sb : (p.g_out_mla - 1024);
      transpose_tile(shm, src, dst, g, K, N, kt, ntile);
    }
    for (int i = 0; i < 4; ++i) {
      const int t = bid * 8 + wid + i * 2048;
      if (t < T_) {
        const float* xr = p.x + (size_t)t * DM; f32x4 v[8]; float ss = 0.f;
#pragma unroll
        for (int j = 0; j < 8; ++j) { v[j] = *(const f32x4*)(xr + j * 256 + lane * 4); ss += (v[j][0] * v[j][0] + v[j][1] * v[j][1]) + (v[j][2] * v[j][2] + v[j][3] * v[j][3]); }
        ss = wave_sum(ss); const float r = rsqrtf(ss * (1.f / 2048.f) + EPS);
#pragma unroll
        for (int j = 0; j < 8; ++j) { const f32x4 g4 = *(const f32x4*)(p.g_attn_pre + j * 256 + lane * 4); const f32x4 y = v[j] * r * g4;
          u32x2 w; w[0] = cvtpk(y[0], y[1]); w[1] = cvtpk(y[2], y[3]); *(u32x2*)(H + (size_t)t * DM + j * 256 + lane * 4) = w; }
      }
    }
    for (int idx = bid * 512 + tid; idx < T_ * 32; idx += nblk * 512) {
      const int t = idx >> 5, fi = idx & 31;
      const float inv = exp2f(-(float)fi * (13.287712379549449f / 32.f));
      const float ang = (float)p.pos[t] * inv;
      double rev = (double)ang * 0.15915494309189535; rev -= floor(rev);
      const float rf = (float)rev;
      COS[idx] = __builtin_amdgcn_cosf(rf); SIN[idx] = __builtin_amdgcn_sinf(rf);
    }
  }
  grid.sync();
  PH(1) { Epi<0> e; e.out = PROJ; e.ldo = INP; e.st_in = nullptr; e.st_out = STC; e.cosT = COS; e.sinT = SIN;
    gemm_phase<0>(shm, H, DM, WIN, 2048, 16, e); }
  grid.sync();
  PH(2) { Epi<1> e; e.out = Q; e.ldo = 1536; e.st_in = STC; e.st_out = nullptr; e.cosT = COS; e.sinT = SIN;
    gemm_phase<1>(shm, PROJ + 3072, INP, WUQ, 512, 6, e);
    Epi<2> e2; e2.out = KV; e2.ldo = 2048; e2.st_in = STC; e2.st_out = nullptr; e2.cosT = nullptr; e2.sinT = nullptr;
    gemm_phase<2>(shm, PROJ + 3584, INP, WUKV, 256, 8, e2); }
  grid.sync();
  PH(3) for (;;) {
    const int tid = opaque_tid();
    if (tid == 0) s_unit = (int)atomicAdd(CNT, 1u);
    __syncthreads();
    const int u = s_unit;
    __syncthreads();
    if (u >= 512) break;
    const int qb = 7 - (u >> 6), idx = u & 63, mla = idx >> 5, b = (idx & 31) >> 3, h = idx & 7;
    const size_t r0 = (size_t)b * SEQ;
    if (mla) attn_unit<true>(shm, Q + r0 * 1536 + h * 192, 1536, KV + r0 * 2048 + h * 256, 2048, PROJ + r0 * INP + 3840, INP, KV + r0 * 2048 + h * 256 + 128, 2048,
                             O + r0 * 2048 + 1024 + h * 128, 2048, STO + r0 * 16 + 8 + h, qb);
    else attn_unit<false>(shm, PROJ + r0 * INP + h * 128, INP, PROJ + r0 * INP + 1024 + h * 128, INP, nullptr, 0, PROJ + r0 * INP + 2048 + h * 128, INP,
                          O + r0 * 2048 + h * 128, 2048, STO + r0 * 16 + h, qb);
  }
  grid.sync();
  PH(4) { Epi<3> e; e.out = Y; e.ldo = 2048; e.st_in = STO; e.st_out = STY; e.cosT = nullptr; e.sinT = nullptr;
    gemm_phase<3>(shm, O, 2048, WO, 2048, 8, e); }
  grid.sync();
  PH(5) for (int i = 0; i < 4; ++i) {
    const int tid = opaque_tid(), wid = tid >> 6, lane = tid & 63;
    const int t = bid * 8 + wid + i * 2048;
    if (t < T_) {
      float s = STY[(size_t)t * 32 + (lane & 31)];
      s += __shfl_xor(s, 16); s += __shfl_xor(s, 8); s += __shfl_xor(s, 4); s += __shfl_xor(s, 2); s += __shfl_xor(s, 1);
      const float r = rsqrtf(s * (1.f / 2048.f) + EPS);
      f32x4 x1[4][2]; float ss = 0.f;
#pragma unroll
      for (int j = 0; j < 4; ++j) {
        const int c = j * 512 + lane * 8;
        const u32x4 yw = *(const u32x4*)(Y + (size_t)t * DM + c);
        const f32x4 xa = *(const f32x4*)(p.x + (size_t)t * DM + c), xb = *(const f32x4*)(p.x + (size_t)t * DM + c + 4);
        const f32x4 ga = *(const f32x4*)(p.g_attn_post + c), gb = *(const f32x4*)(p.g_attn_post + c + 4);
        const f32x4 ya = {bf_lo(yw[0]), bf_hi(yw[0]), bf_lo(yw[1]), bf_hi(yw[1])}, yb = {bf_lo(yw[2]), bf_hi(yw[2]), bf_lo(yw[3]), bf_hi(yw[3])};
        x1[j][0] = xa + ya * r * ga; x1[j][1] = xb + yb * r * gb;
        *(f32x4*)(p.out + (size_t)t * DM + c) = x1[j][0]; *(f32x4*)(p.out + (size_t)t * DM + c + 4) = x1[j][1];
#pragma unroll
        for (int q = 0; q < 2; ++q) ss += (x1[j][q][0] * x1[j][q][0] + x1[j][q][1] * x1[j][q][1]) + (x1[j][q][2] * x1[j][q][2] + x1[j][q][3] * x1[j][q][3]);
      }
      ss = wave_sum(ss); const float r2 = rsqrtf(ss * (1.f / 2048.f) + EPS);
#pragma unroll
      for (int j = 0; j < 4; ++j) {
        const int c = j * 512 + lane * 8;
        const f32x4 ga = *(const f32x4*)(p.g_ffn_pre + c), gb = *(const f32x4*)(p.g_ffn_pre + c + 4);
        const f32x4 ha = x1[j][0] * r2 * ga, hb = x1[j][1] * r2 * gb;
        u32x4 w; w[0] = cvtpk(ha[0], ha[1]); w[1] = cvtpk(ha[2], ha[3]); w[2] = cvtpk(hb[0], hb[1]); w[3] = cvtpk(hb[2], hb[3]);
        *(u32x4*)(H + (size_t)t * DM + c) = w;
      }
    }
  }
  grid.sync();
  PH(6) { Epi<4> e; e.out = UP; e.ldo = DFF2; e.st_in = nullptr; e.st_out = nullptr; e.cosT = nullptr; e.sinT = nullptr;
    gemm_phase<4>(shm, H, DM, WUP, 2048, 44, e); }
  grid.sync();
  PH(7) for (int task = bid * 512 + opaque_tid(); task < 512 * 704; task += nblk * 512) {
    const int chunk = task / 704, oct = task - chunk * 704, c = oct * 8, t0 = chunk * 16;
    f32x4 wg[3][2], wv[3][2], bg[2], bv[2];
#pragma unroll
    for (int j = 0; j < 3; ++j)
#pragma unroll
      for (int q = 0; q < 2; ++q) { wg[j][q] = *(const f32x4*)(p.conv_w + (size_t)j * DFF2 + c + q * 4); wv[j][q] = *(const f32x4*)(p.conv_w + (size_t)j * DFF2 + DFF + c + q * 4); }
#pragma unroll
    for (int q = 0; q < 2; ++q) { bg[q] = *(const f32x4*)(p.conv_b + c + q * 4); bv[q] = *(const f32x4*)(p.conv_b + DFF + c + q * 4); }
    u32x4 g2 = {0u, 0u, 0u, 0u}, g1 = g2, v2 = g2, v1 = g2;
    if ((t0 & (SEQ - 1)) != 0) {
      g2 = *(const u32x4*)(UP + (size_t)(t0 - 2) * DFF2 + c); g1 = *(const u32x4*)(UP + (size_t)(t0 - 1) * DFF2 + c);
      v2 = *(const u32x4*)(UP + (size_t)(t0 - 2) * DFF2 + DFF + c); v1 = *(const u32x4*)(UP + (size_t)(t0 - 1) * DFF2 + DFF + c);
    }
#pragma unroll 4
    for (int r = 0; r < 16; ++r) {
      const u32x4 g0 = *(const u32x4*)(UP + (size_t)(t0 + r) * DFF2 + c), v0 = *(const u32x4*)(UP + (size_t)(t0 + r) * DFF2 + DFF + c);
      u32x4 w;
#pragma unroll
      for (int q = 0; q < 4; ++q) {
        const int hq = q >> 1, e0 = (q & 1) * 2;
        const float ug0 = wg[0][hq][e0] * bf_lo(g2[q]) + wg[1][hq][e0] * bf_lo(g1[q]) + wg[2][hq][e0] * bf_lo(g0[q]) + bg[hq][e0];
        const float ug1 = wg[0][hq][e0 + 1] * bf_hi(g2[q]) + wg[1][hq][e0 + 1] * bf_hi(g1[q]) + wg[2][hq][e0 + 1] * bf_hi(g0[q]) + bg[hq][e0 + 1];
        const float uv0 = wv[0][hq][e0] * bf_lo(v2[q]) + wv[1][hq][e0] * bf_lo(v1[q]) + wv[2][hq][e0] * bf_lo(v0[q]) + bv[hq][e0];
        const float uv1 = wv[0][hq][e0 + 1] * bf_hi(v2[q]) + wv[1][hq][e0 + 1] * bf_hi(v1[q]) + wv[2][hq][e0 + 1] * bf_hi(v0[q]) + bv[hq][e0 + 1];
        w[q] = cvtpk(gelu_tanh(ug0) * uv0, gelu_tanh(ug1) * uv1);
      }
      *(u32x4*)(ACT + (size_t)(t0 + r) * DFF + c) = w;
      g2 = g1; g1 = g0; v2 = v1; v1 = v0;
    }
  }
  grid.sync();
  PH(8) { Epi<5> e; e.out = Y2; e.ldo = 2048; e.st_in = nullptr; e.st_out = STY2; e.cosT = nullptr; e.sinT = nullptr;
    gemm_phase<5>(shm, ACT, DFF, WDN, DFF, 8, e); }
  grid.sync();
  PH(9) for (int i = 0; i < 4; ++i) {
    const int tid = opaque_tid(), wid = tid >> 6, lane = tid & 63;
    const int t = bid * 8 + wid + i * 2048;
    if (t < T_) {
      float s = STY2[(size_t)t * 32 + (lane & 31)];
      s += __shfl_xor(s, 16); s += __shfl_xor(s, 8); s += __shfl_xor(s, 4); s += __shfl_xor(s, 2); s += __shfl_xor(s, 1);
      const float r = rsqrtf(s * (1.f / 2048.f) + EPS);
#pragma unroll
      for (int j = 0; j < 4; ++j) {
        const int c = j * 512 + lane * 8;
        const u32x4 yw = *(const u32x4*)(Y2 + (size_t)t * DM + c);
        const f32x4 xa = *(const f32x4*)(p.out + (size_t)t * DM + c), xb = *(const f32x4*)(p.out + (size_t)t * DM + c + 4);
        const f32x4 ga = *(const f32x4*)(p.g_ffn_post + c), gb = *(const f32x4*)(p.g_ffn_post + c + 4);
        const f32x4 ya = {bf_lo(yw[0]), bf_hi(yw[0]), bf_lo(yw[1]), bf_hi(yw[1])}, yb = {bf_lo(yw[2]), bf_hi(yw[2]), bf_lo(yw[3]), bf_hi(yw[3])};
        *(f32x4*)(p.out + (size_t)t * DM + c) = xa + ya * r * ga; *(f32x4*)(p.out + (size_t)t * DM + c + 4) = xb + yb * r * gb;
      }
    }
  }
}

extern "C" void kernel_launch(void* const* d_in, const int* in_sizes, int n_in, void* d_out, int out_size, void* d_ws, size_t ws_size, hipStream_t stream) {
  if (n_in != 18 || ws_size < WS_END) { fprintf(stderr, "kernel_launch: unexpected n_in %d / ws_size %zu (need %zu)\n", n_in, ws_size, (size_t)WS_END); return; }
  static int grid_blocks = 0;
  if (!grid_blocks) {
    int dev = 0, cus = 0, per_cu = 0;
    (void)hipGetDevice(&dev);
    (void)hipDeviceGetAttribute(&cus, hipDeviceAttributeMultiprocessorCount, dev);
    (void)hipOccupancyMaxActiveBlocksPerMultiprocessor(&per_cu, fwd_kernel, 512, 0);
    if (per_cu < 1) per_cu = 1;
    grid_blocks = cus;
  }
  Params p{};
  p.x = (const float*)d_in[0]; p.pos = (const int*)d_in[1]; p.g_attn_pre = (const float*)d_in[2]; p.w_in = (const float*)d_in[3]; p.g_cq = (const float*)d_in[4];
  p.w_uq = (const float*)d_in[5]; p.g_ckv = (const float*)d_in[6]; p.w_ukv = (const float*)d_in[7]; p.g_out_sb = (const float*)d_in[8]; p.g_out_mla = (const float*)d_in[9];
  p.w_o = (const float*)d_in[10]; p.g_attn_post = (const float*)d_in[11]; p.g_ffn_pre = (const float*)d_in[12]; p.w_up = (const float*)d_in[13]; p.conv_w = (const float*)d_in[14];
  p.conv_b = (const float*)d_in[15]; p.w_down = (const float*)d_in[16]; p.g_ffn_post = (const float*)d_in[17]; p.out = (float*)d_out; p.ws = (char*)d_ws;
  void* args[] = {&p};
  hipError_t e = hipLaunchCooperativeKernel((void*)fwd_kernel, dim3(grid_blocks), dim3(512), args, 0, stream);
  if (e != hipSuccess) fprintf(stderr, "cooperative launch failed: %s (grid %d)\n", hipGetErrorString(e), grid_blocks);
}
```

```cpp
#include <hip/hip_runtime.h>
#include <hip/hip_bf16.h>
#include <hip/hip_cooperative_groups.h>
#include <cstdio>
#include <cstdint>
namespace cg = cooperative_groups;

typedef unsigned short bf16_t;
using bf16x8 = __attribute__((ext_vector_type(8))) short;
using s16x4  = __attribute__((ext_vector_type(4))) short;
using f32x4  = __attribute__((ext_vector_type(4))) float;
using f32x16 = __attribute__((ext_vector_type(16))) float;
using u32x4  = __attribute__((ext_vector_type(4))) unsigned;
using u32x2  = __attribute__((ext_vector_type(2))) unsigned;
using i32x4  = __attribute__((ext_vector_type(4))) int;
#define DEV __device__ __forceinline__
#define LDS_AS __attribute__((address_space(3)))
#define GLB_AS __attribute__((address_space(1)))
#define SBAR() __builtin_amdgcn_sched_barrier(0)

constexpr int T_ = 8192, DM = 2048, SEQ = 2048;
constexpr int INC = 3904, INP = 4096, DFF = 5632, DFF2 = 11264;
constexpr float EPS = 1e-6f;
#ifndef PHASES
#define PHASES 0x3ff
#endif
#ifndef REPMASK
#define REPMASK 0
#endif
#define EXTRA_SYNC 0
#define PH(k) if constexpr ((PHASES >> (k)) & 1) for (int rep_ = 0; rep_ < 1 + ((REPMASK >> (k)) & 1); ++rep_)
constexpr size_t MiB = 1024 * 1024;
constexpr size_t OFF_WIN = 0, OFF_WUQ = 16 * MiB, OFF_WUKV = OFF_WUQ + 3 * MiB / 2, OFF_WO = OFF_WUKV + MiB, OFF_H = OFF_WO + 8 * MiB,
                 OFF_Y = OFF_H + 32 * MiB, OFF_ACT = 0, OFF_WUP = OFF_Y + 32 * MiB, OFF_WDN = OFF_WUP + 44 * MiB, OFF_UP = OFF_WDN + 22 * MiB,
                 OFF_PROJ = OFF_UP, OFF_Q = OFF_UP + 64 * MiB, OFF_KV = OFF_Q + 24 * MiB, OFF_O = OFF_KV + 32 * MiB, OFF_Y2 = OFF_UP,
                 OFF_COS = OFF_UP + 176 * MiB, OFF_SIN = OFF_COS + MiB, OFF_STC = OFF_SIN + MiB, OFF_STO = OFF_STC + MiB / 2,
                 OFF_STY = OFF_STO + MiB / 2, OFF_STY2 = OFF_STY + MiB, OFF_CNT = OFF_STY2 + MiB, WS_END = OFF_CNT + 16384;

struct Params {
  const float* x; const int* pos; const float* g_attn_pre; const float* w_in; const float* g_cq; const float* w_uq; const float* g_ckv; const float* w_ukv;
  const float* g_out_sb; const float* g_out_mla; const float* w_o; const float* g_attn_post; const float* g_ffn_pre; const float* w_up; const float* conv_w;
  const float* conv_b; const float* w_down; const float* g_ffn_post; float* out; char* ws;
};

DEV unsigned cvtpk(float lo, float hi) { unsigned r; asm volatile("v_cvt_pk_bf16_f32 %0, %1, %2" : "=v"(r) : "v"(lo), "v"(hi)); return r; }
DEV float bf_lo(unsigned w) { return __uint_as_float(w << 16); }
DEV float bf_hi(unsigned w) { return __uint_as_float(w & 0xffff0000u); }
DEV int crow(int r, int hi) { return (r & 3) + 8 * (r >> 2) + 4 * hi; }
DEV int opaque_tid() { int t = threadIdx.x; asm volatile("" : "+v"(t)); return t; }
DEV float wave_sum(float s) {
  s += __shfl_xor(s, 32); s += __shfl_xor(s, 16); s += __shfl_xor(s, 8); s += __shfl_xor(s, 4); s += __shfl_xor(s, 2); s += __shfl_xor(s, 1); return s;
}

DEV const char* uptr(const void* p) {
  const unsigned long long v = (unsigned long long)p;
  const unsigned lo = __builtin_amdgcn_readfirstlane((unsigned)v), hi = __builtin_amdgcn_readfirstlane((unsigned)(v >> 32));
  return (const char*)(((unsigned long long)hi << 32) | lo);
}

#define XB_TMO      128
#define XB_XCNT(j)  (256  + 64 * (j))
#define XB_XSUB(j)  (1280 + 64 * (j))
#define XB_XGEN(j)  (2304 + 64 * (j))
#define XB_TOP      3328
#define XB_TOPGEN   3392
#define XB_QCNT     3456
#define XCD_BAR_WORDS 3520
#define XB_SPIN_CAP (1u << 18)
DEV unsigned xb_ld(unsigned* p)              { return __hip_atomic_load(p, __ATOMIC_RELAXED, __HIP_MEMORY_SCOPE_AGENT); }
DEV unsigned xb_add(unsigned* p, unsigned v) { return __hip_atomic_fetch_add(p, v, __ATOMIC_RELAXED, __HIP_MEMORY_SCOPE_AGENT); }
DEV unsigned xb_xcc_id() { return (unsigned)__builtin_amdgcn_s_getreg((3 << 11) | 20) & 0xFu; }
#define XB_SPIN(cond, bar) do { unsigned _sp = 0; while (cond) { __builtin_amdgcn_s_sleep(1); \
    if ((++_sp & 255u) == 0u) { if (xb_ld(&(bar)[XB_TMO])) break; if (_sp > XB_SPIN_CAP) { atomicAdd(&(bar)[XB_TMO], 1u); break; } } } } while (0)
struct XcdBarrier { unsigned* bar; unsigned x; volatile LDS_AS unsigned* st; };
DEV XcdBarrier xcd_barrier_post(unsigned* bar, volatile LDS_AS unsigned* st) {
  XcdBarrier b; b.bar = bar; b.x = xb_xcc_id(); b.st = st;
  if (threadIdx.x == 0) (void)xb_add(&bar[XB_XCNT(b.x)], 1u);
  return b;
}
DEV void xcd_barrier_complete(unsigned* bar, unsigned x, unsigned& nloc, unsigned& nx) {
  const unsigned G = gridDim.x * gridDim.y * gridDim.z;
  unsigned sum, cnt, mine, sp = 0u;
  for (;;) {
    sum = 0u; cnt = 0u; mine = 0u;
#pragma unroll
    for (unsigned j = 0; j < 16; ++j) { const unsigned c = xb_ld(&bar[XB_XCNT(j)]); sum += c; cnt += (c > 0u) ? 1u : 0u; mine = (j == x) ? c : mine; }
    if (sum == G) break;
    __builtin_amdgcn_s_sleep(1);
    if ((++sp & 255u) == 0u) { if (xb_ld(&bar[XB_TMO])) break; if (sp > XB_SPIN_CAP) { atomicAdd(&bar[XB_TMO], 1u); break; } }
  }
  nloc = mine > 0u ? mine : 1u; nx = cnt > 0u ? cnt : 1u;
}
DEV void xcd_barrier(const XcdBarrier& b) {
  asm volatile("s_waitcnt vmcnt(0)" ::: "memory");
  __syncthreads();
  if (threadIdx.x == 0) {
    unsigned* bar = b.bar;
    __builtin_amdgcn_s_waitcnt(0);
    unsigned nloc = b.st[0], nx = b.st[1];
    if (nloc == 0u) { xcd_barrier_complete(bar, b.x, nloc, nx); b.st[0] = nloc; b.st[1] = nx; }
    const unsigned old = xb_add(&bar[XB_XSUB(b.x)], 1u);
    const unsigned gen = old / nloc;
    if (old + 1u == (gen + 1u) * nloc) {
      __builtin_amdgcn_fence(__ATOMIC_RELEASE, "agent");
      asm volatile("s_waitcnt vmcnt(0)" ::: "memory");
      const unsigned og = xb_add(&bar[XB_TOP], 1u);
      const unsigned tg = og / nx;
      if (og + 1u == (tg + 1u) * nx) xb_add(&bar[XB_TOPGEN], 1u);
      else XB_SPIN(xb_ld(&bar[XB_TOPGEN]) == tg, bar);
      __builtin_amdgcn_fence(__ATOMIC_ACQUIRE, "agent");
      xb_add(&bar[XB_XGEN(b.x)], 1u);
      asm volatile("s_waitcnt vmcnt(0)" ::: "memory");
    } else {
      XB_SPIN(xb_ld(&bar[XB_XGEN(b.x)]) == gen, bar);
      __builtin_amdgcn_fence(__ATOMIC_ACQUIRE, "agent");
      asm volatile("s_waitcnt vmcnt(0)" ::: "memory");
    }
  }
  __syncthreads();
}
DEV int lds_byte2(int r, int c) { int st = (r >> 4) * 2 + (c >> 5), ob = (r & 15) * 64 + (c & 31) * 2; return st * 1024 + (ob ^ (((ob >> 9) & 1) << 5)); }
DEV void stage_rc2(int b, int& R, int& C) { int st = b >> 10, sb = b & 1023, swz = sb ^ (((sb >> 9) & 1) << 5); R = (st >> 1) * 16 + swz / 64; C = (st & 1) * 32 + (swz % 64) / 2; }

template <int MODE> struct Epi {
  bf16_t* out; int ldo; const float* st_in; float* st_out; const float* cosT; const float* sinT;
  DEV void prep(float* rsc, int row0, int tid) const {
    if (tid < 256) {
      const float* sp = st_in + (size_t)(row0 + tid) * 16;
      const f32x4 a0 = *(const f32x4*)(sp), a1 = *(const f32x4*)(sp + 4), b0 = *(const f32x4*)(sp + 8), b1 = *(const f32x4*)(sp + 12);
      const float ssb = (a0[0] + a0[1]) + (a0[2] + a0[3]) + (a1[0] + a1[1]) + (a1[2] + a1[3]);
      const float sml = (b0[0] + b0[1]) + (b0[2] + b0[3]) + (b1[0] + b1[1]) + (b1[2] + b1[3]);
      const float rsb = rsqrtf(ssb * (1.f / 1024.f) + EPS), rml = rsqrtf(sml * (1.f / 1024.f) + EPS);
      rsc[tid] = rsb / rml; rsc[256 + tid] = rml;
    }
  }
  DEV void hook(f32x4 (&acc)[8][4], const float* rsc, int rloc, int fr) const {
#pragma unroll
    for (int m = 0; m < 8; ++m) {
      const float ratio = rsc[rloc + m * 16 + fr];
#pragma unroll
      for (int n = 0; n < 4; ++n) acc[m][n] *= ratio;
    }
  }
  DEV void operator()(const f32x4 (&acc)[8][4], int rbase, int cbase, int fr, int fq, const float* rsc) const {
    const bool do_rope = MODE == 0 ? (cbase == 3840) : (MODE == 1 ? ((cbase % 192) == 128) : false);
    const bool do_stat = MODE == 0 ? (cbase >= 3072 && cbase < 3840) : (MODE == 3 || MODE == 5);
    const int slot = MODE == 0 ? ((cbase - 3072) >> 6) : (cbase >> 6);
    constexpr int SS = MODE == 0 ? 16 : 32;
#pragma unroll
    for (int m = 0; m < 8; ++m) {
      const int row = rbase + m * 16 + fr;
      float rs = 1.f;
      if (MODE == 1) { const float* sp = st_in + (size_t)row * 16; const f32x4 a0 = *(const f32x4*)(sp), a1 = *(const f32x4*)(sp + 4);
        rs = rsqrtf(((a0[0] + a0[1]) + (a0[2] + a0[3]) + (a1[0] + a1[1]) + (a1[2] + a1[3])) * (1.f / 512.f) + EPS); }
      if (MODE == 2) { const f32x4 a0 = *(const f32x4*)(st_in + (size_t)row * 16 + 8); rs = rsqrtf(((a0[0] + a0[1]) + (a0[2] + a0[3])) * (1.f / 256.f) + EPS); }
      if (MODE == 3) rs = rsc[256 + (row & 255)];
      f32x4 v[4];
#pragma unroll
      for (int n = 0; n < 4; ++n) v[n] = acc[m][n] * rs;
      if (MODE <= 1) {
        if (do_rope) {
          const f32x4 c0 = *(const f32x4*)(cosT + (size_t)row * 32 + fq * 4), c1 = *(const f32x4*)(cosT + (size_t)row * 32 + 16 + fq * 4);
          const f32x4 s0 = *(const f32x4*)(sinT + (size_t)row * 32 + fq * 4), s1 = *(const f32x4*)(sinT + (size_t)row * 32 + 16 + fq * 4);
          const f32x4 x1a = v[0], x2a = v[2], x1b = v[1], x2b = v[3];
          v[0] = x1a * c0 - x2a * s0; v[2] = x1a * s0 + x2a * c0; v[1] = x1b * c1 - x2b * s1; v[3] = x1b * s1 + x2b * c1;
        }
      }
      if (MODE == 0 || MODE == 3 || MODE == 5) {
        if (do_stat) {
          float s = 0.f;
#pragma unroll
          for (int n = 0; n < 4; ++n) s += (v[n][0] * v[n][0] + v[n][1] * v[n][1]) + (v[n][2] * v[n][2] + v[n][3] * v[n][3]);
          s += __shfl_xor(s, 16); s += __shfl_xor(s, 32);
          *(GLB_AS float*)((GLB_AS char*)uptr(st_out) + (unsigned)(row * SS + slot) * 4u) = s;
        }
      }
      GLB_AS char* ob = (GLB_AS char*)uptr(out); const unsigned oo = (unsigned)(row * ldo + cbase + fq * 4) * 2u;
#pragma unroll
      for (int n = 0; n < 4; ++n) { u32x2 w; w[0] = cvtpk(v[n][0], v[n][1]); w[1] = cvtpk(v[n][2], v[n][3]); *(GLB_AS u32x2*)(ob + oo + n * 32) = w; }
      asm volatile("" ::: "memory");
    }
  }
};

template <int MODE>
DEV void gemm_phase(char* shm, float* rowsc, const bf16_t* __restrict__ A, int lda, const bf16_t* __restrict__ Bt, int K, int nN, const Epi<MODE>& epi) {
  constexpr int TILE_B = 32768, STAGE_B = 65536;
  const int tid = opaque_tid(), wid = tid >> 6, lane = tid & 63, wr = wid >> 2, wc = wid & 3, fr = lane & 15, fq = lane >> 4;
  unsigned oA[4], oB[4];
#pragma unroll
  for (int i = 0; i < 4; ++i) { int R, C; stage_rc2(wid * 1024 + i * 8192 + lane * 16, R, C); oA[i] = (unsigned)(R * lda + C) * 2u; oB[i] = (unsigned)(R * K + C) * 2u; }
  const int nt = K >> 6, nUnits = 32 * nN;
  LDS_AS char* lshm = (LDS_AS char*)shm;
#define G_SA(b) (shm + (b) * STAGE_B)
#define G_SB(b) (shm + (b) * STAGE_B + TILE_B)
#define G_STAGE(buf, kt) do { const char* a_ = uptr(Ab + (kt) * 64); const char* b_ = uptr(Bb + (kt) * 64); _Pragma("unroll") for (int i = 0; i < 4; ++i) { \
      __builtin_amdgcn_global_load_lds((const unsigned*)(a_ + oA[i]), (LDS_AS unsigned*)(lshm + (buf) * STAGE_B + wid * 1024 + i * 8192), 16, 0, 0); \
      __builtin_amdgcn_global_load_lds((const unsigned*)(b_ + oB[i]), (LDS_AS unsigned*)(lshm + (buf) * STAGE_B + TILE_B + wid * 1024 + i * 8192), 16, 0, 0); } } while (0)
#define G_KSTEP(buf, ks) do { bf16x8 At[8], Bf[4]; \
      _Pragma("unroll") for (int m = 0; m < 8; ++m) At[m] = *(const LDS_AS bf16x8*)(lshm + (buf) * STAGE_B + aoff + m * 2048 + (ks) * 1024); \
      _Pragma("unroll") for (int n = 0; n < 4; ++n) Bf[n] = *(const LDS_AS bf16x8*)(lshm + (buf) * STAGE_B + TILE_B + boff + n * 2048 + (ks) * 1024); \
      _Pragma("unroll") for (int m = 0; m < 8; ++m) _Pragma("unroll") for (int n = 0; n < 4; ++n) \
        acc[m][n] = __builtin_amdgcn_mfma_f32_16x16x32_bf16(Bf[n], At[m], acc[m][n], 0, 0, 0); SBAR(); } while (0)
  const int aoff = lds_byte2(wr * 128 + fr, fq * 8), boff = lds_byte2(wc * 64 + fr, fq * 8);
  int ui = 0;
  for (int u = blockIdx.x; u < nUnits; u += gridDim.x, ++ui) {
    const int pm = (u & 15) + 16 * (u / (16 * nN)), pn = (u >> 4) % nN;
    float* rsc = rowsc + (ui & 1) * 512;
    if (MODE == 3) epi.prep(rsc, pm * 256, tid);
    const bf16_t* Ab = A + (size_t)pm * 256 * lda; const bf16_t* Bb = Bt + (size_t)pn * 256 * K;
    f32x4 acc[8][4];
#pragma unroll
    for (int m = 0; m < 8; ++m)
#pragma unroll
      for (int n = 0; n < 4; ++n) acc[m][n] = (f32x4){0.f, 0.f, 0.f, 0.f};
    G_STAGE(0, 0); asm volatile("s_waitcnt vmcnt(0)" ::: "memory"); __syncthreads();
    for (int t = 0; t < nt; ++t) {
      const int cur = t & 1;
      if (t + 1 < nt) G_STAGE(cur ^ 1, t + 1);
      if (MODE == 3) { if (t == 16) { const int t2 = opaque_tid(); epi.hook(acc, rsc, ((t2 >> 8) & 1) * 128, t2 & 15); } }
      G_KSTEP(cur, 0); G_KSTEP(cur, 1);
      asm volatile("s_waitcnt vmcnt(0)" ::: "memory"); __syncthreads();
    }
    { const int t2 = opaque_tid(); epi(acc, pm * 256 + ((t2 >> 8) & 1) * 128, pn * 256 + ((t2 >> 6) & 3) * 64, t2 & 15, (t2 >> 4) & 3, rsc); }
  }
#undef G_SA
#undef G_SB
#undef G_STAGE
#undef G_KSTEP
}

DEV int v_st(int k, int c) { const int kk = (k & ~0xC) | ((k & 4) << 1) | ((k & 8) >> 1); return ((kk >> 3) * 4 + (c >> 5)) * 512 + ((kk & 7) * 32 + (c & 31)) * 2; }
DEV int v_rd_base(int lane) { return ((lane & 3) << 3) | (((lane >> 2) & 3) << 6) | (((lane >> 4) & 1) << 5) | (((lane >> 5) & 1) << 8); }
constexpr int v_rd_off(int d0, int ks, int half) { return d0 * 512 + ks * 4096 + half * 2048; }
template <int OFF> DEV s16x4 tr_read(int vb) { s16x4 r; asm volatile("ds_read_b64_tr_b16 %0, %1 offset:%2" : "=&v"(r) : "v"(vb), "i"(OFF) : "memory"); return r; }
template <int D0> DEV void pv_one(f32x16& od, int vb, bf16x8 pa0, bf16x8 pa1, bf16x8 pa2, bf16x8 pa3) {
  const s16x4 l0 = tr_read<v_rd_off(D0, 0, 0)>(vb), h0 = tr_read<v_rd_off(D0, 0, 1)>(vb), l1 = tr_read<v_rd_off(D0, 1, 0)>(vb), h1 = tr_read<v_rd_off(D0, 1, 1)>(vb);
  const s16x4 l2 = tr_read<v_rd_off(D0, 2, 0)>(vb), h2 = tr_read<v_rd_off(D0, 2, 1)>(vb), l3 = tr_read<v_rd_off(D0, 3, 0)>(vb), h3 = tr_read<v_rd_off(D0, 3, 1)>(vb);
  asm volatile("s_waitcnt lgkmcnt(0)" ::: "memory"); SBAR();
#define PKV(L, H) (bf16x8){L[0], L[1], L[2], L[3], H[0], H[1], H[2], H[3]}
  od = __builtin_amdgcn_mfma_f32_32x32x16_bf16(pa0, PKV(l0, h0), od, 0, 0, 0);
  od = __builtin_amdgcn_mfma_f32_32x32x16_bf16(pa1, PKV(l1, h1), od, 0, 0, 0);
  od = __builtin_amdgcn_mfma_f32_32x32x16_bf16(pa2, PKV(l2, h2), od, 0, 0, 0);
  od = __builtin_amdgcn_mfma_f32_32x32x16_bf16(pa3, PKV(l3, h3), od, 0, 0, 0);
#undef PKV
}
#define PK4(P, BASE, OUT) do { unsigned a0_ = cvtpk(P[BASE + 0], P[BASE + 1]), a1_ = cvtpk(P[BASE + 2], P[BASE + 3]);   \
    unsigned b0_ = cvtpk(P[BASE + 4], P[BASE + 5]), b1_ = cvtpk(P[BASE + 6], P[BASE + 7]);                              \
    auto r0_ = __builtin_amdgcn_permlane32_swap(a0_, b0_, false, false); auto r1_ = __builtin_amdgcn_permlane32_swap(a1_, b1_, false, false); \
    u32x4 w_ = {r0_[0], r1_[0], r0_[1], r1_[1]}; OUT = *reinterpret_cast<bf16x8*>(&w_); } while (0)

DEV void sb_half(f32x16& P, float& run, bool diag, int key0, int qrow, int hi) {
  constexpr float C = 0.08838834764831845f * 1.4426950408889634f;
#pragma unroll
  for (int r = 0; r < 16; ++r) P[r] *= C;
  if (diag) {
#pragma unroll
    for (int r = 0; r < 16; ++r) { if (key0 + crow(r, hi) >= qrow) P[r] = -1e30f; }
  }
  f32x16 L;
#pragma unroll
  for (int r = 0; r < 16; ++r) L[r] = -(fmaxf(P[r], 0.f) + __builtin_amdgcn_logf(1.f + __builtin_amdgcn_exp2f(-fabsf(P[r]))));
#pragma unroll
  for (int g = 3; g >= 0; --g) {
    const float gs = (L[4 * g] + L[4 * g + 1]) + (L[4 * g + 2] + L[4 * g + 3]);
    auto rr = __builtin_amdgcn_permlane32_swap(__float_as_uint(gs), __float_as_uint(gs), false, false);
    const float lo = __uint_as_float(rr[0]), hv = __uint_as_float(rr[1]);
    const float e3 = run + (hi == 0 ? hv : 0.f), e2 = e3 + L[4 * g + 3], e1 = e2 + L[4 * g + 2], e0 = e1 + L[4 * g + 1];
    run += lo + hv;
    P[4 * g + 3] = __builtin_amdgcn_exp2f(P[4 * g + 3] + L[4 * g + 3] + e3); P[4 * g + 2] = __builtin_amdgcn_exp2f(P[4 * g + 2] + L[4 * g + 2] + e2);
    P[4 * g + 1] = __builtin_amdgcn_exp2f(P[4 * g + 1] + L[4 * g + 1] + e1); P[4 * g + 0] = __builtin_amdgcn_exp2f(P[4 * g + 0] + L[4 * g + 0] + e0);
  }
}
DEV void sb_tile(f32x16& p0, f32x16& p1, float& carry, bool diag, int kt0, int qrow, int hi) {
  sb_half(p1, carry, diag, kt0 + 32, qrow, hi);
  sb_half(p0, carry, diag, kt0, qrow, hi);
}

template <bool MLA>
DEV void attn_unit(char* lds, const bf16_t* __restrict__ Qb, int ldq, const bf16_t* __restrict__ Kb, int ldk, const bf16_t* __restrict__ Krb, int ldkr,
                   const bf16_t* __restrict__ Vb, int ldv, bf16_t* __restrict__ Ob, int ldo, float* __restrict__ statb, int qb) {
  constexpr int DQ = MLA ? 192 : 128, ND = DQ / 16, ROWB = DQ * 2, SHMK = 64 * ROWB, SHMV = 16384, BUF = SHMK + SHMV;
#define KSWZ(row, colB) ((row) * ROWB + ((colB) ^ (((row) & 7) << 4)))
  const int tid = opaque_tid(), wid = tid >> 6, lane = tid & 63, r32 = lane & 31, hi = lane >> 5;
  float* al_l = (float*)(lds + 2 * BUF + wid * 256); float* li_l = al_l + 32;
  const int q0w = 256 * qb + 32 * wid, qrow = q0w + r32;
  bf16x8 qr[ND];
  { const bf16_t* Qw = Qb + (size_t)qrow * ldq + hi * 8;
#pragma unroll
    for (int d0 = 0; d0 < ND; ++d0) qr[d0] = *(const bf16x8*)(Qw + d0 * 16); }
  f32x16 o[4];
#pragma unroll
  for (int d = 0; d < 4; ++d)
#pragma unroll
    for (int r = 0; r < 16; ++r) o[d][r] = 0.f;
  float carry = 0.f, m_reg = -1e30f, l_reg = 0.f;
  const int NT = 4 * qb + 4, jmax = 4 * qb + (wid >> 1);
  const int sr = tid >> 4, sc = (tid & 15) * 8, vst0 = v_st(sr, sc), vst1 = v_st(32 + sr, sc), krr = tid >> 3, krc = (tid & 7) * 8;
  const int vb0 = (int)(unsigned)(uintptr_t)(lds + SHMK) + v_rd_base(lane);
  bf16x8 ks0, ks1, vs0, vs1, kx;
#define A_LOAD(jt) do { const int kt0_ = (jt) * 64; \
    ks0 = *(const bf16x8*)(Kb + (size_t)(kt0_ + sr) * ldk + sc); ks1 = *(const bf16x8*)(Kb + (size_t)(kt0_ + 32 + sr) * ldk + sc); \
    vs0 = *(const bf16x8*)(Vb + (size_t)(kt0_ + sr) * ldv + sc); vs1 = *(const bf16x8*)(Vb + (size_t)(kt0_ + 32 + sr) * ldv + sc); \
    if (MLA) kx = *(const bf16x8*)(Krb + (size_t)(kt0_ + krr) * ldkr + krc); SBAR(); } while (0)
#define A_WRITE(b) do { char* base_ = lds + (b) * BUF; \
    *(bf16x8*)(base_ + KSWZ(sr, sc * 2)) = ks0; *(bf16x8*)(base_ + KSWZ(32 + sr, sc * 2)) = ks1; \
    *(bf16x8*)(base_ + SHMK + vst0) = vs0; *(bf16x8*)(base_ + SHMK + vst1) = vs1; \
    if (MLA) *(bf16x8*)(base_ + KSWZ(krr, (128 + krc) * 2)) = kx; } while (0)
  A_LOAD(NT - 1); A_WRITE(0); A_LOAD(NT - 2); __syncthreads();
  for (int i = 0; i < NT; ++i) {
    const int jt = NT - 1 - i, cur = i & 1;
    if (i + 1 < NT) A_WRITE(cur ^ 1);
    if (jt > jmax) { if (i + 2 < NT) A_LOAD(jt - 2); }
    else {
      const char* Kl = lds + cur * BUF;
      f32x16 p0, p1;
#pragma unroll
      for (int r = 0; r < 16; ++r) { p0[r] = 0.f; p1[r] = 0.f; }
#pragma unroll
      for (int d0 = 0; d0 < ND; ++d0) {
        const int cb = (d0 * 16 + hi * 8) * 2;
        const bf16x8 b0 = *(const bf16x8*)(Kl + KSWZ(r32, cb));
        const bf16x8 b1 = *(const bf16x8*)(Kl + KSWZ(32 + r32, cb));
        p0 = __builtin_amdgcn_mfma_f32_32x32x16_bf16(b0, qr[d0], p0, 0, 0, 0);
        p1 = __builtin_amdgcn_mfma_f32_32x32x16_bf16(b1, qr[d0], p1, 0, 0, 0);
      }
      if (MLA) {
        constexpr float C2 = 0.07216878364870323f * 1.4426950408889634f;
        float pmax = p0[0];
#pragma unroll
        for (int r = 1; r < 16; ++r) pmax = fmaxf(pmax, p0[r]);
#pragma unroll
        for (int r = 0; r < 16; ++r) pmax = fmaxf(pmax, p1[r]);
        { auto rr = __builtin_amdgcn_permlane32_swap(__float_as_uint(pmax), __float_as_uint(pmax), false, false);
          pmax = fmaxf(__uint_as_float(rr[0]), __uint_as_float(rr[1])); }
        const float mn = fmaxf(m_reg, pmax), alpha = __builtin_amdgcn_exp2f((m_reg - mn) * C2); m_reg = mn;
        const float mnC = -mn * C2;
        float ps = 0.f;
#pragma unroll
        for (int r = 0; r < 16; ++r) { p0[r] = __builtin_amdgcn_exp2f(fmaf(p0[r], C2, mnC)); p1[r] = __builtin_amdgcn_exp2f(fmaf(p1[r], C2, mnC)); ps += p0[r] + p1[r]; }
        { auto rr = __builtin_amdgcn_permlane32_swap(__float_as_uint(ps), __float_as_uint(ps), false, false);
          ps = __uint_as_float(rr[0]) + __uint_as_float(rr[1]); }
        l_reg = l_reg * alpha + ps;
        if (__any(alpha < 1.f)) {
          if (hi == 0) al_l[r32] = alpha;
          asm volatile("s_waitcnt lgkmcnt(0)" ::: "memory");
#pragma unroll
          for (int r = 0; r < 16; ++r) { const float a = al_l[crow(r, hi)];
#pragma unroll
            for (int d = 0; d < 4; ++d) o[d][r] *= a; }
        }
      } else {
        sb_tile(p0, p1, carry, jt == jmax, jt * 64, qrow, hi);
      }
      bf16x8 pa0, pa1, pa2, pa3;
      PK4(p0, 0, pa0); PK4(p0, 8, pa1); PK4(p1, 0, pa2); PK4(p1, 8, pa3);
      if (i + 2 < NT) A_LOAD(jt - 2);
      const int vb = vb0 + cur * BUF;
      pv_one<0>(o[0], vb, pa0, pa1, pa2, pa3); pv_one<1>(o[1], vb, pa0, pa1, pa2, pa3); pv_one<2>(o[2], vb, pa0, pa1, pa2, pa3); pv_one<3>(o[3], vb, pa0, pa1, pa2, pa3);
    }
    __syncthreads();
  }
  if (MLA) {
    if (hi == 0) li_l[r32] = l_reg;
    asm volatile("s_waitcnt lgkmcnt(0)" ::: "memory");
#pragma unroll
    for (int r = 0; r < 16; ++r) { const float rl = 1.f / li_l[crow(r, hi)];
#pragma unroll
      for (int d = 0; d < 4; ++d) o[d][r] *= rl; }
  }
#pragma unroll
  for (int r = 0; r < 16; ++r) {
    const int orow = q0w + crow(r, hi);
    float s = (o[0][r] * o[0][r] + o[1][r] * o[1][r]) + (o[2][r] * o[2][r] + o[3][r] * o[3][r]);
    s += __shfl_xor(s, 16); s += __shfl_xor(s, 8); s += __shfl_xor(s, 4); s += __shfl_xor(s, 2); s += __shfl_xor(s, 1);
    if (r32 == 0) statb[(size_t)orow * 16] = s;
#pragma unroll
    for (int d = 0; d < 4; ++d) Ob[(size_t)orow * ldo + d * 32 + r32] = (bf16_t)(cvtpk(o[d][r], o[d][r]) & 0xffffu);
  }
#undef A_LOAD
#undef A_WRITE
#undef KSWZ
}

DEV void transpose_tile(char* shm, const float* __restrict__ src, bf16_t* __restrict__ dst, const float* __restrict__ g, int K, int N, int kt, int ntile) {
  float* tile = (float*)shm;
  const int tid = opaque_tid(), k0 = kt * 64, n0 = ntile * 256, n4 = (tid & 63) * 4, kr = tid >> 6;
#pragma unroll
  for (int i = 0; i < 8; ++i) {
    const int k = kr + 8 * i; f32x4 v = {0.f, 0.f, 0.f, 0.f};
    if (n0 + n4 < N) v = *(const f32x4*)(src + (size_t)(k0 + k) * N + n0 + n4);
    if (g) v *= g[k0 + k];
    tile[k * 257 + n4 + 0] = v[0]; tile[k * 257 + n4 + 1] = v[1]; tile[k * 257 + n4 + 2] = v[2]; tile[k * 257 + n4 + 3] = v[3];
  }
  __syncthreads();
  const int n = tid >> 1, kh = (tid & 1) * 32;
#pragma unroll
  for (int q = 0; q < 4; ++q) {
    u32x4 w;
#pragma unroll
    for (int j = 0; j < 4; ++j) w[j] = cvtpk(tile[(kh + 8 * q + 2 * j) * 257 + n], tile[(kh + 8 * q + 2 * j + 1) * 257 + n]);
    *(u32x4*)(dst + (size_t)(n0 + n) * K + k0 + kh + 8 * q) = w;
  }
  __syncthreads();
}

DEV float gelu_tanh(float x) {
  const float u = x + 0.044715f * x * x * x;
  return x * __builtin_amdgcn_rcpf(1.f + __builtin_amdgcn_exp2f(-2.302208198f * u));
}

__global__ void __launch_bounds__(512, 2) fwd_kernel(Params p) {
  __shared__ __attribute__((aligned(1024))) char shm[131072];
  __shared__ int s_unit;
  __shared__ float rowsc[1024];
  __shared__ uint4 xb_words;
  cg::grid_group grid = cg::this_grid();
  if (threadIdx.x == 0) xb_words = make_uint4(0u, 0u, 0u, 0u);
  __syncthreads();
  unsigned* BAR = (unsigned*)(p.ws + OFF_CNT);
  const XcdBarrier xb = xcd_barrier_post(BAR, (volatile LDS_AS unsigned*)&xb_words);
  if (p.ws == nullptr) grid.sync();
  const int bid = blockIdx.x, nblk = gridDim.x;
  char* ws = p.ws;
  bf16_t* WIN = (bf16_t*)(ws + OFF_WIN); bf16_t* WUQ = (bf16_t*)(ws + OFF_WUQ); bf16_t* WUKV = (bf16_t*)(ws + OFF_WUKV); bf16_t* WO = (bf16_t*)(ws + OFF_WO);
  bf16_t* H = (bf16_t*)(ws + OFF_H); bf16_t* Y = (bf16_t*)(ws + OFF_Y); bf16_t* ACT = (bf16_t*)(ws + OFF_ACT); bf16_t* WUP = (bf16_t*)(ws + OFF_WUP);
  bf16_t* WDN = (bf16_t*)(ws + OFF_WDN); bf16_t* UP = (bf16_t*)(ws + OFF_UP); bf16_t* PROJ = (bf16_t*)(ws + OFF_PROJ); bf16_t* Q = (bf16_t*)(ws + OFF_Q);
  bf16_t* KV = (bf16_t*)(ws + OFF_KV); bf16_t* O = (bf16_t*)(ws + OFF_O); bf16_t* Y2 = (bf16_t*)(ws + OFF_Y2);
  float* COS = (float*)(ws + OFF_COS); float* SIN = (float*)(ws + OFF_SIN); float* STC = (float*)(ws + OFF_STC); float* STO = (float*)(ws + OFF_STO);
  float* STY = (float*)(ws + OFF_STY); float* STY2 = (float*)(ws + OFF_STY2); unsigned* CNT = BAR + XB_QCNT;

  PH(0) {
    const int tid = opaque_tid(), wid = tid >> 6, lane = tid & 63;
    for (int ti = bid; ti < 2960; ti += nblk) {
      const float* src; bf16_t* dst; const float* g = nullptr; int K, N, ntn, loc;
      if (ti < 512) { src = p.w_in; dst = WIN; K = 2048; N = INC; ntn = 16; loc = ti; }
      else if (ti < 560) { src = p.w_uq; dst = WUQ; g = p.g_cq; K = 512; N = 1536; ntn = 6; loc = ti - 512; }
      else if (ti < 592) { src = p.w_ukv; dst = WUKV; g = p.g_ckv; K = 256; N = 2048; ntn = 8; loc = ti - 560; }
      else if (ti < 848) { src = p.w_o; dst = WO; K = 2048; N = 2048; ntn = 8; loc = ti - 592; }
      else if (ti < 2256) { src = p.w_up; dst = WUP; K = 2048; N = DFF2; ntn = 44; loc = ti - 848; }
      else { src = p.w_down; dst = WDN; K = DFF; N = 2048; ntn = 8; loc = ti - 2256; }
      const int kt = loc / ntn, ntile = loc % ntn;
      if (ti >= 592 && ti < 848) g = (kt < 16) ? p.g_out_sb : (p.g_out_mla - 1024);
      transpose_tile(shm, src, dst, g, K, N, kt, ntile);
    }
    for (int i = 0; i < 4; ++i) {
      const int t = bid * 8 + wid + i * 2048;
      if (t < T_) {
        const float* xr = p.x + (size_t)t * DM; f32x4 v[8]; float ss = 0.f;
#pragma unroll
        for (int j = 0; j < 8; ++j) { v[j] = *(const f32x4*)(xr + j * 256 + lane * 4); ss += (v[j][0] * v[j][0] + v[j][1] * v[j][1]) + (v[j][2] * v[j][2] + v[j][3] * v[j][3]); }
        ss = wave_sum(ss); const float r = rsqrtf(ss * (1.f / 2048.f) + EPS);
#pragma unroll
        for (int j = 0; j < 8; ++j) { const f32x4 g4 = *(const f32x4*)(p.g_attn_pre + j * 256 + lane * 4); const f32x4 y = v[j] * r * g4;
          u32x2 w; w[0] = cvtpk(y[0], y[1]); w[1] = cvtpk(y[2], y[3]); *(u32x2*)(H + (size_t)t * DM + j * 256 + lane * 4) = w; }
      }
    }
    for (int idx = bid * 512 + tid; idx < T_ * 32; idx += nblk * 512) {
      const int t = idx >> 5, fi = idx & 31;
      const float inv = exp2f(-(float)fi * (13.287712379549449f / 32.f));
      const float ang = (float)p.pos[t] * inv;
      double rev = (double)ang * 0.15915494309189535; rev -= floor(rev);
      const float rf = (float)rev;
      COS[idx] = __builtin_amdgcn_cosf(rf); SIN[idx] = __builtin_amdgcn_sinf(rf);
    }
  }
  xcd_barrier(xb);
  for (int es_ = 0; es_ < EXTRA_SYNC; ++es_) xcd_barrier(xb);
  PH(1) { Epi<0> e; e.out = PROJ; e.ldo = INP; e.st_in = nullptr; e.st_out = STC; e.cosT = COS; e.sinT = SIN;
    gemm_phase<0>(shm, rowsc, H, DM, WIN, 2048, 16, e); }
  xcd_barrier(xb);
  PH(2) { Epi<1> e; e.out = Q; e.ldo = 1536; e.st_in = STC; e.st_out = nullptr; e.cosT = COS; e.sinT = SIN;
    gemm_phase<1>(shm, rowsc, PROJ + 3072, INP, WUQ, 512, 6, e);
    Epi<2> e2; e2.out = KV; e2.ldo = 2048; e2.st_in = STC; e2.st_out = nullptr; e2.cosT = nullptr; e2.sinT = nullptr;
    gemm_phase<2>(shm, rowsc, PROJ + 3584, INP, WUKV, 256, 8, e2); }
  xcd_barrier(xb);
  PH(3) for (;;) {
    const int tid = opaque_tid();
    if (tid == 0) s_unit = (int)atomicAdd(CNT + rep_, 1u);
    __syncthreads();
    const int u = s_unit;
    __syncthreads();
    if (u >= 512) break;
    const int qb = 7 - (u >> 6), idx = u & 63, mla = idx >> 5, b = (idx & 31) >> 3, h = idx & 7;
    const size_t r0 = (size_t)b * SEQ;
    if (mla) attn_unit<true>(shm, Q + r0 * 1536 + h * 192, 1536, KV + r0 * 2048 + h * 256, 2048, PROJ + r0 * INP + 3840, INP, KV + r0 * 2048 + h * 256 + 128, 2048,
                             O + r0 * 2048 + 1024 + h * 128, 2048, STO + r0 * 16 + 8 + h, qb);
    else attn_unit<false>(shm, PROJ + r0 * INP + h * 128, INP, PROJ + r0 * INP + 1024 + h * 128, INP, nullptr, 0, PROJ + r0 * INP + 2048 + h * 128, INP,
                          O + r0 * 2048 + h * 128, 2048, STO + r0 * 16 + h, qb);
  }
  xcd_barrier(xb);
  PH(4) { Epi<3> e; e.out = Y; e.ldo = 2048; e.st_in = STO; e.st_out = STY; e.cosT = nullptr; e.sinT = nullptr;
    gemm_phase<3>(shm, rowsc, O, 2048, WO, 2048, 8, e); }
  xcd_barrier(xb);
  PH(5) for (int i = 0; i < 4; ++i) {
    const int tid = opaque_tid(), wid = tid >> 6, lane = tid & 63;
    const int t = bid * 8 + wid + i * 2048;
    if (t < T_) {
      float s = STY[(size_t)t * 32 + (lane & 31)];
      s += __shfl_xor(s, 16); s += __shfl_xor(s, 8); s += __shfl_xor(s, 4); s += __shfl_xor(s, 2); s += __shfl_xor(s, 1);
      const float r = rsqrtf(s * (1.f / 2048.f) + EPS);
      f32x4 x1[4][2]; float ss = 0.f;
#pragma unroll
      for (int j = 0; j < 4; ++j) {
        const int c = j * 512 + lane * 8;
        const u32x4 yw = *(const u32x4*)(Y + (size_t)t * DM + c);
        const f32x4 xa = *(const f32x4*)(p.x + (size_t)t * DM + c), xb = *(const f32x4*)(p.x + (size_t)t * DM + c + 4);
        const f32x4 ga = *(const f32x4*)(p.g_attn_post + c), gb = *(const f32x4*)(p.g_attn_post + c + 4);
        const f32x4 ya = {bf_lo(yw[0]), bf_hi(yw[0]), bf_lo(yw[1]), bf_hi(yw[1])}, yb = {bf_lo(yw[2]), bf_hi(yw[2]), bf_lo(yw[3]), bf_hi(yw[3])};
        x1[j][0] = xa + ya * r * ga; x1[j][1] = xb + yb * r * gb;
        *(f32x4*)(p.out + (size_t)t * DM + c) = x1[j][0]; *(f32x4*)(p.out + (size_t)t * DM + c + 4) = x1[j][1];
#pragma unroll
        for (int q = 0; q < 2; ++q) ss += (x1[j][q][0] * x1[j][q][0] + x1[j][q][1] * x1[j][q][1]) + (x1[j][q][2] * x1[j][q][2] + x1[j][q][3] * x1[j][q][3]);
      }
      ss = wave_sum(ss); const float r2 = rsqrtf(ss * (1.f / 2048.f) + EPS);
#pragma unroll
      for (int j = 0; j < 4; ++j) {
        const int c = j * 512 + lane * 8;
        const f32x4 ga = *(const f32x4*)(p.g_ffn_pre + c), gb = *(const f32x4*)(p.g_ffn_pre + c + 4);
        const f32x4 ha = x1[j][0] * r2 * ga, hb = x1[j][1] * r2 * gb;
        u32x4 w; w[0] = cvtpk(ha[0], ha[1]); w[1] = cvtpk(ha[2], ha[3]); w[2] = cvtpk(hb[0], hb[1]); w[3] = cvtpk(hb[2], hb[3]);
        *(u32x4*)(H + (size_t)t * DM + c) = w;
      }
    }
  }
  xcd_barrier(xb);
  PH(6) { Epi<4> e; e.out = UP; e.ldo = DFF2; e.st_in = nullptr; e.st_out = nullptr; e.cosT = nullptr; e.sinT = nullptr;
    gemm_phase<4>(shm, rowsc, H, DM, WUP, 2048, 44, e); }
  xcd_barrier(xb);
  PH(7) for (int task = bid * 512 + opaque_tid(); task < 512 * 704; task += nblk * 512) {
    const int chunk = task / 704, oct = task - chunk * 704, c = oct * 8, t0 = chunk * 16;
    f32x4 wg[3][2], wv[3][2], bg[2], bv[2];
#pragma unroll
    for (int j = 0; j < 3; ++j)
#pragma unroll
      for (int q = 0; q < 2; ++q) { wg[j][q] = *(const f32x4*)(p.conv_w + (size_t)j * DFF2 + c + q * 4); wv[j][q] = *(const f32x4*)(p.conv_w + (size_t)j * DFF2 + DFF + c + q * 4); }
#pragma unroll
    for (int q = 0; q < 2; ++q) { bg[q] = *(const f32x4*)(p.conv_b + c + q * 4); bv[q] = *(const f32x4*)(p.conv_b + DFF + c + q * 4); }
    u32x4 g2 = {0u, 0u, 0u, 0u}, g1 = g2, v2 = g2, v1 = g2;
    if ((t0 & (SEQ - 1)) != 0) {
      g2 = *(const u32x4*)(UP + (size_t)(t0 - 2) * DFF2 + c); g1 = *(const u32x4*)(UP + (size_t)(t0 - 1) * DFF2 + c);
      v2 = *(const u32x4*)(UP + (size_t)(t0 - 2) * DFF2 + DFF + c); v1 = *(const u32x4*)(UP + (size_t)(t0 - 1) * DFF2 + DFF + c);
    }
#pragma unroll 4
    for (int r = 0; r < 16; ++r) {
      const u32x4 g0 = *(const u32x4*)(UP + (size_t)(t0 + r) * DFF2 + c), v0 = *(const u32x4*)(UP + (size_t)(t0 + r) * DFF2 + DFF + c);
      u32x4 w;
#pragma unroll
      for (int q = 0; q < 4; ++q) {
        const int hq = q >> 1, e0 = (q & 1) * 2;
        const float ug0 = wg[0][hq][e0] * bf_lo(g2[q]) + wg[1][hq][e0] * bf_lo(g1[q]) + wg[2][hq][e0] * bf_lo(g0[q]) + bg[hq][e0];
        const float ug1 = wg[0][hq][e0 + 1] * bf_hi(g2[q]) + wg[1][hq][e0 + 1] * bf_hi(g1[q]) + wg[2][hq][e0 + 1] * bf_hi(g0[q]) + bg[hq][e0 + 1];
        const float uv0 = wv[0][hq][e0] * bf_lo(v2[q]) + wv[1][hq][e0] * bf_lo(v1[q]) + wv[2][hq][e0] * bf_lo(v0[q]) + bv[hq][e0];
        const float uv1 = wv[0][hq][e0 + 1] * bf_hi(v2[q]) + wv[1][hq][e0 + 1] * bf_hi(v1[q]) + wv[2][hq][e0 + 1] * bf_hi(v0[q]) + bv[hq][e0 + 1];
        w[q] = cvtpk(gelu_tanh(ug0) * uv0, gelu_tanh(ug1) * uv1);
      }
      *(u32x4*)(ACT + (size_t)(t0 + r) * DFF + c) = w;
      g2 = g1; g1 = g0; v2 = v1; v1 = v0;
    }
  }
  xcd_barrier(xb);
  PH(8) { Epi<5> e; e.out = Y2; e.ldo = 2048; e.st_in = nullptr; e.st_out = STY2; e.cosT = nullptr; e.sinT = nullptr;
    gemm_phase<5>(shm, rowsc, ACT, DFF, WDN, DFF, 8, e); }
  xcd_barrier(xb);
  PH(9) for (int i = 0; i < 4; ++i) {
    const int tid = opaque_tid(), wid = tid >> 6, lane = tid & 63;
    const int t = bid * 8 + wid + i * 2048;
    if (t < T_) {
      float s = STY2[(size_t)t * 32 + (lane & 31)];
      s += __shfl_xor(s, 16); s += __shfl_xor(s, 8); s += __shfl_xor(s, 4); s += __shfl_xor(s, 2); s += __shfl_xor(s, 1);
      const float r = rsqrtf(s * (1.f / 2048.f) + EPS);
#pragma unroll
      for (int j = 0; j < 4; ++j) {
        const int c = j * 512 + lane * 8;
        const u32x4 yw = *(const u32x4*)(Y2 + (size_t)t * DM + c);
        const f32x4 xa = *(const f32x4*)(p.out + (size_t)t * DM + c), xb = *(const f32x4*)(p.out + (size_t)t * DM + c + 4);
        const f32x4 ga = *(const f32x4*)(p.g_ffn_post + c), gb = *(const f32x4*)(p.g_ffn_post + c + 4);
        const f32x4 ya = {bf_lo(yw[0]), bf_hi(yw[0]), bf_lo(yw[1]), bf_hi(yw[1])}, yb = {bf_lo(yw[2]), bf_hi(yw[2]), bf_lo(yw[3]), bf_hi(yw[3])};
        *(f32x4*)(p.out + (size_t)t * DM + c) = xa + ya * r * ga; *(f32x4*)(p.out + (size_t)t * DM + c + 4) = xb + yb * r * gb;
      }
    }
  }
}

extern "C" void kernel_launch(void* const* d_in, const int* in_sizes, int n_in, void* d_out, int out_size, void* d_ws, size_t ws_size, hipStream_t stream) {
  if (n_in != 18 || ws_size < WS_END) { fprintf(stderr, "kernel_launch: unexpected n_in %d / ws_size %zu (need %zu)\n", n_in, ws_size, (size_t)WS_END); return; }
  static int grid_blocks = 0;
  if (!grid_blocks) {
    int dev = 0, cus = 0, per_cu = 0;
    (void)hipGetDevice(&dev);
    (void)hipDeviceGetAttribute(&cus, hipDeviceAttributeMultiprocessorCount, dev);
    (void)hipOccupancyMaxActiveBlocksPerMultiprocessor(&per_cu, fwd_kernel, 512, 0);
    if (per_cu < 1) per_cu = 1;
    grid_blocks = cus;
  }
  Params p{};
  p.x = (const float*)d_in[0]; p.pos = (const int*)d_in[1]; p.g_attn_pre = (const float*)d_in[2]; p.w_in = (const float*)d_in[3]; p.g_cq = (const float*)d_in[4];
  p.w_uq = (const float*)d_in[5]; p.g_ckv = (const float*)d_in[6]; p.w_ukv = (const float*)d_in[7]; p.g_out_sb = (const float*)d_in[8]; p.g_out_mla = (const float*)d_in[9];
  p.w_o = (const float*)d_in[10]; p.g_attn_post = (const float*)d_in[11]; p.g_ffn_pre = (const float*)d_in[12]; p.w_up = (const float*)d_in[13]; p.conv_w = (const float*)d_in[14];
  p.conv_b = (const float*)d_in[15]; p.w_down = (const float*)d_in[16]; p.g_ffn_post = (const float*)d_in[17]; p.out = (float*)d_out; p.ws = (char*)d_ws;
  (void)hipMemsetAsync((char*)d_ws + OFF_CNT, 0, 16384, stream);
  void* args[] = {&p};
  hipError_t e = hipLaunchCooperativeKernel((void*)fwd_kernel, dim3(grid_blocks), dim3(512), args, 0, stream);
  if (e != hipSuccess) fprintf(stderr, "cooperative launch failed: %s (grid %d)\n", hipGetErrorString(e), grid_blocks);
}
```

```cpp
#include <hip/hip_runtime.h>
#include <hip/hip_bf16.h>
#include <hip/hip_cooperative_groups.h>
#include <cstdio>
#include <cstdint>
namespace cg = cooperative_groups;

typedef unsigned short bf16_t;
using bf16x8 = __attribute__((ext_vector_type(8))) short;
using s16x4  = __attribute__((ext_vector_type(4))) short;
using f32x4  = __attribute__((ext_vector_type(4))) float;
using f32x16 = __attribute__((ext_vector_type(16))) float;
using u32x4  = __attribute__((ext_vector_type(4))) unsigned;
using u32x2  = __attribute__((ext_vector_type(2))) unsigned;
using i32x4  = __attribute__((ext_vector_type(4))) int;
#define DEV __device__ __forceinline__
#define LDS_AS __attribute__((address_space(3)))
#define GLB_AS __attribute__((address_space(1)))
#define SBAR() __builtin_amdgcn_sched_barrier(0)

constexpr int T_ = 8192, DM = 2048, SEQ = 2048;
constexpr int INC = 3904, INP = 4096, DFF = 5632, DFF2 = 11264;
constexpr float EPS = 1e-6f;
#ifndef PHASES
#define PHASES 0x3ff
#endif
#ifndef REPMASK
#define REPMASK 0
#endif
#define EXTRA_SYNC 0
#define AMP_PHASE -1
#define PH(k) if constexpr ((PHASES >> (k)) & 1) for (int rep_ = 0; rep_ < 1 + ((REPMASK >> (k)) & 1); ++rep_)
constexpr size_t MiB = 1024 * 1024;
constexpr size_t OFF_WIN = 0, OFF_WUQ = 16 * MiB, OFF_WUKV = OFF_WUQ + 3 * MiB / 2, OFF_WO = OFF_WUKV + MiB, OFF_H = OFF_WO + 8 * MiB,
                 OFF_Y = OFF_H + 32 * MiB, OFF_WUP = OFF_Y + 32 * MiB, OFF_WDN = OFF_WUP + 44 * MiB, OFF_UP = OFF_WDN + 22 * MiB,
                 OFF_PROJ = OFF_UP, OFF_Q = OFF_UP + 64 * MiB, OFF_KV = OFF_Q + 24 * MiB, OFF_O = OFF_KV + 32 * MiB, OFF_ACT = OFF_UP, OFF_Y2 = OFF_UP + 88 * MiB, OFF_HB = OFF_UP + 120 * MiB,
                 OFF_COS = OFF_UP + 176 * MiB, OFF_SIN = OFF_COS + MiB, OFF_STC = OFF_SIN + MiB, OFF_STO = OFF_STC + MiB / 2,
                 OFF_STY = OFF_STO + MiB / 2, OFF_STY2 = OFF_STY + MiB, OFF_KR = OFF_STY2 + MiB, OFF_CNT = OFF_KR + MiB, WS_END = OFF_CNT + 16384;

struct Params {
  const float* x; const int* pos; const float* g_attn_pre; const float* w_in; const float* g_cq; const float* w_uq; const float* g_ckv; const float* w_ukv;
  const float* g_out_sb; const float* g_out_mla; const float* w_o; const float* g_attn_post; const float* g_ffn_pre; const float* w_up; const float* conv_w;
  const float* conv_b; const float* w_down; const float* g_ffn_post; float* out; char* ws;
};

DEV unsigned cvtpk(float lo, float hi) { unsigned r; asm volatile("v_cvt_pk_bf16_f32 %0, %1, %2" : "=v"(r) : "v"(lo), "v"(hi)); return r; }
DEV float bf_lo(unsigned w) { return __uint_as_float(w << 16); }
DEV float bf_hi(unsigned w) { return __uint_as_float(w & 0xffff0000u); }
DEV int crow(int r, int hi) { return (r & 3) + 8 * (r >> 2) + 4 * hi; }
DEV int opaque_tid() { int t = threadIdx.x; asm volatile("" : "+v"(t)); return t; }
DEV float wave_sum(float s) {
  s += __shfl_xor(s, 32); s += __shfl_xor(s, 16); s += __shfl_xor(s, 8); s += __shfl_xor(s, 4); s += __shfl_xor(s, 2); s += __shfl_xor(s, 1); return s;
}

DEV const char* uptr(const void* p) {
  const unsigned long long v = (unsigned long long)p;
  const unsigned lo = __builtin_amdgcn_readfirstlane((unsigned)v), hi = __builtin_amdgcn_readfirstlane((unsigned)(v >> 32));
  return (const char*)(((unsigned long long)hi << 32) | lo);
}

#define XB_TMO      128
#define XB_XCNT(j)  (256  + 64 * (j))
#define XB_XSUB(j)  (1280 + 64 * (j))
#define XB_XGEN(j)  (2304 + 64 * (j))
#define XB_TOP      3328
#define XB_TOPGEN   3392
#define XB_QCNT     3456
#define XCD_BAR_WORDS 3520
#define XB_SPIN_CAP (1u << 18)
DEV unsigned xb_ld(unsigned* p)              { return __hip_atomic_load(p, __ATOMIC_RELAXED, __HIP_MEMORY_SCOPE_AGENT); }
DEV unsigned xb_add(unsigned* p, unsigned v) { return __hip_atomic_fetch_add(p, v, __ATOMIC_RELAXED, __HIP_MEMORY_SCOPE_AGENT); }
DEV unsigned xb_xcc_id() { return (unsigned)__builtin_amdgcn_s_getreg((3 << 11) | 20) & 0xFu; }
#define XB_SPIN(cond, bar) do { unsigned _sp = 0; while (cond) { __builtin_amdgcn_s_sleep(1); \
    if ((++_sp & 255u) == 0u) { if (xb_ld(&(bar)[XB_TMO])) break; if (_sp > XB_SPIN_CAP) { atomicAdd(&(bar)[XB_TMO], 1u); break; } } } } while (0)
struct XcdBarrier { unsigned* bar; unsigned x; volatile LDS_AS unsigned* st; };
DEV XcdBarrier xcd_barrier_post(unsigned* bar, volatile LDS_AS unsigned* st) {
  XcdBarrier b; b.bar = bar; b.x = xb_xcc_id(); b.st = st;
  if (threadIdx.x == 0) (void)xb_add(&bar[XB_XCNT(b.x)], 1u);
  return b;
}
DEV void xcd_barrier_complete(unsigned* bar, unsigned x, unsigned& nloc, unsigned& nx) {
  const unsigned G = gridDim.x * gridDim.y * gridDim.z;
  unsigned sum, cnt, mine, sp = 0u;
  for (;;) {
    sum = 0u; cnt = 0u; mine = 0u;
#pragma unroll
    for (unsigned j = 0; j < 16; ++j) { const unsigned c = xb_ld(&bar[XB_XCNT(j)]); sum += c; cnt += (c > 0u) ? 1u : 0u; mine = (j == x) ? c : mine; }
    if (sum == G) break;
    __builtin_amdgcn_s_sleep(1);
    if ((++sp & 255u) == 0u) { if (xb_ld(&bar[XB_TMO])) break; if (sp > XB_SPIN_CAP) { atomicAdd(&bar[XB_TMO], 1u); break; } }
  }
  nloc = mine > 0u ? mine : 1u; nx = cnt > 0u ? cnt : 1u;
}
DEV void xcd_barrier(const XcdBarrier& b) {
  asm volatile("s_waitcnt vmcnt(0)" ::: "memory");
  __syncthreads();
  if (threadIdx.x == 0) {
    unsigned* bar = b.bar;
    __builtin_amdgcn_s_waitcnt(0);
    unsigned nloc = b.st[0], nx = b.st[1];
    if (nloc == 0u) { xcd_barrier_complete(bar, b.x, nloc, nx); b.st[0] = nloc; b.st[1] = nx; }
    const unsigned old = xb_add(&bar[XB_XSUB(b.x)], 1u);
    const unsigned gen = old / nloc;
    if (old + 1u == (gen + 1u) * nloc) {
      __builtin_amdgcn_fence(__ATOMIC_RELEASE, "agent");
      asm volatile("s_waitcnt vmcnt(0)" ::: "memory");
      const unsigned og = xb_add(&bar[XB_TOP], 1u);
      const unsigned tg = og / nx;
      if (og + 1u == (tg + 1u) * nx) xb_add(&bar[XB_TOPGEN], 1u);
      else XB_SPIN(xb_ld(&bar[XB_TOPGEN]) == tg, bar);
      __builtin_amdgcn_fence(__ATOMIC_ACQUIRE, "agent");
      xb_add(&bar[XB_XGEN(b.x)], 1u);
      asm volatile("s_waitcnt vmcnt(0)" ::: "memory");
    } else {
      XB_SPIN(xb_ld(&bar[XB_XGEN(b.x)]) == gen, bar);
      __builtin_amdgcn_fence(__ATOMIC_ACQUIRE, "agent");
      asm volatile("s_waitcnt vmcnt(0)" ::: "memory");
    }
  }
  __syncthreads();
}
DEV int lds_byte2(int r, int c) { int st = (r >> 4) * 2 + (c >> 5), ob = (r & 15) * 64 + (c & 31) * 2; return st * 1024 + (ob ^ (((ob >> 9) & 1) << 5)); }
DEV void stage_rc2(int b, int& R, int& C) { int st = b >> 10, sb = b & 1023, swz = sb ^ (((sb >> 9) & 1) << 5); R = (st >> 1) * 16 + swz / 64; C = (st & 1) * 32 + (swz % 64) / 2; }

DEV float gelu_tanh(float x) {
  const float u = x + 0.044715f * x * x * x;
  return x * __builtin_amdgcn_rcpf(1.f + __builtin_amdgcn_exp2f(-2.302208198f * u));
}

DEV float dpp_shr1(float old, float src) {
  return __int_as_float(__builtin_amdgcn_update_dpp(__float_as_int(old), __float_as_int(src), 0x111, 0xf, 0xf, false));
}
DEV void epi_up(const f32x4 (&acc)[2][2][4][2], int pm, int pn, int wr, int wc, int fr, int fq, float* halo, bf16_t* ACTp, float* HB, const float* conv_w, const float* conv_b) {
  if (fr == 15) {
#pragma unroll
    for (int ai = 0; ai < 2; ++ai)
#pragma unroll
      for (int rs = 0; rs < 2; ++rs)
#pragma unroll
        for (int bj = 0; bj < 2; ++bj)
#pragma unroll
          for (int n = 0; n < 2; ++n) *(f32x4*)(halo + (((ai * 2 + wr) * 4 + wc) * 2 + rs) * 64 + (bj * 2 + n) * 16 + fq * 4) = acc[ai][bj][2 + rs][n];
  }
  {
    GLB_AS char* hb = (GLB_AS char*)uptr(HB);
    if (wr == 1 && fr == 15) {
#pragma unroll
      for (int rs = 0; rs < 2; ++rs)
#pragma unroll
        for (int bj = 0; bj < 2; ++bj)
#pragma unroll
          for (int n = 0; n < 2; ++n) *(GLB_AS f32x4*)(hb + (unsigned)((pm * 4 + rs) * DFF2 + pn * 256 + bj * 128 + wc * 32 + 8 * fq + 4 * n) * 4u) = acc[1][bj][2 + rs][n];
    }
    if (wr == 0 && fr == 0) {
#pragma unroll
      for (int rs = 0; rs < 2; ++rs)
#pragma unroll
        for (int bj = 0; bj < 2; ++bj)
#pragma unroll
          for (int n = 0; n < 2; ++n) *(GLB_AS f32x4*)(hb + (unsigned)((pm * 4 + 2 + rs) * DFF2 + pn * 256 + bj * 128 + wc * 32 + 8 * fq + 4 * n) * 4u) = acc[0][bj][rs][n];
    }
  }
  asm volatile("s_waitcnt lgkmcnt(0)" ::: "memory"); __builtin_amdgcn_s_barrier(); asm volatile("" ::: "memory");
  GLB_AS char* ap = (GLB_AS char*)uptr(ACTp);
#pragma unroll
  for (int n = 0; n < 2; ++n) {
    const int chb = pn * 128 + wc * 32 + 8 * fq + 4 * n;
    const f32x4 wg0 = *(const f32x4*)(conv_w + chb), wg1 = *(const f32x4*)(conv_w + DFF2 + chb), wg2 = *(const f32x4*)(conv_w + 2 * DFF2 + chb), bg = *(const f32x4*)(conv_b + chb);
    const f32x4 wv0 = *(const f32x4*)(conv_w + DFF + chb), wv1 = *(const f32x4*)(conv_w + DFF2 + DFF + chb), wv2 = *(const f32x4*)(conv_w + 2 * DFF2 + DFF + chb), bv = *(const f32x4*)(conv_b + DFF + chb);
#pragma unroll
    for (int ai = 0; ai < 2; ++ai) {
      f32x4 hg2 = {0.f, 0.f, 0.f, 0.f}, hg3 = hg2, hv2 = hg2, hv3 = hg2;
      if ((wr == 1 || ai == 1) && fr == 0) {
        const int sai = wr == 1 ? ai : 0, swr = wr == 1 ? 0 : 1;
        const float* hp = halo + ((sai * 2 + swr) * 4 + wc) * 128 + fq * 4;
        hg2 = *(const f32x4*)(hp + n * 16); hv2 = *(const f32x4*)(hp + (2 + n) * 16); hg3 = *(const f32x4*)(hp + 64 + n * 16); hv3 = *(const f32x4*)(hp + 64 + (2 + n) * 16);
      }
      f32x4 sg2, sg3, sv2, sv3;
#pragma unroll
      for (int j = 0; j < 4; ++j) {
        sg2[j] = dpp_shr1(hg2[j], acc[ai][0][2][n][j]); sg3[j] = dpp_shr1(hg3[j], acc[ai][0][3][n][j]);
        sv2[j] = dpp_shr1(hv2[j], acc[ai][1][2][n][j]); sv3[j] = dpp_shr1(hv3[j], acc[ai][1][3][n][j]);
      }
#pragma unroll
      for (int m = 0; m < 4; ++m) {
        const f32x4 cg = acc[ai][0][m][n], cv = acc[ai][1][m][n];
        const f32x4 g1 = m == 0 ? sg3 : acc[ai][0][m == 0 ? 0 : m - 1][n], g2 = m == 0 ? sg2 : (m == 1 ? sg3 : acc[ai][0][m < 2 ? 0 : m - 2][n]);
        const f32x4 v1 = m == 0 ? sv3 : acc[ai][1][m == 0 ? 0 : m - 1][n], v2 = m == 0 ? sv2 : (m == 1 ? sv3 : acc[ai][1][m < 2 ? 0 : m - 2][n]);
        const f32x4 ug = wg2 * cg + wg1 * g1 + wg0 * g2 + bg, uv = wv2 * cv + wv1 * v1 + wv0 * v2 + bv;
        const int row = pm * 256 + ai * 128 + wr * 64 + 4 * fr + m;
        u32x2 w; w[0] = cvtpk(gelu_tanh(ug[0]) * uv[0], gelu_tanh(ug[1]) * uv[1]); w[1] = cvtpk(gelu_tanh(ug[2]) * uv[2], gelu_tanh(ug[3]) * uv[3]);
        *(GLB_AS u32x2*)(ap + (unsigned)(row * DFF + chb) * 2u) = w;
      }
      asm volatile("" ::: "memory");
    }
  }
}

DEV int perm32(int rho) { const int n = rho >> 4, i = rho & 15; return 8 * (i >> 2) + 4 * n + (i & 3); }
struct Unit { int pm, pn; };
struct Sched {
  int nN, nUnits, G, c;
  DEV bool next(int i, Unit& u) const { const int L = i * G + c; if (L >= nUnits) return false; u.pm = (L & 15) + 16 * (L / (16 * nN)); u.pn = (L >> 4) % nN; return true; }
};
template <int MODE> struct Epi {
  bf16_t* out; int ldo; const float* st_in; float* st_out; bf16_t* outK; bf16_t* outV;
  DEV void prep(float* rsc, int row0, int tid) const {
    if (tid < 256) {
      const float* sp = st_in + (size_t)(row0 + tid) * 16;
      const f32x4 a0 = *(const f32x4*)(sp), a1 = *(const f32x4*)(sp + 4), b0 = *(const f32x4*)(sp + 8), b1 = *(const f32x4*)(sp + 12);
      const float ssb = (a0[0] + a0[1]) + (a0[2] + a0[3]) + (a1[0] + a1[1]) + (a1[2] + a1[3]);
      const float sml = (b0[0] + b0[1]) + (b0[2] + b0[3]) + (b1[0] + b1[1]) + (b1[2] + b1[3]);
      const float rsb = rsqrtf(ssb * (1.f / 1024.f) + EPS), rml = rsqrtf(sml * (1.f / 1024.f) + EPS);
      rsc[tid] = rsb / rml; rsc[256 + tid] = rml;
    }
  }
  DEV void hook(f32x4 (&acc)[2][2][4][2], const float* rsc, int wr, int fr) const {
#pragma unroll
    for (int ai = 0; ai < 2; ++ai)
#pragma unroll
      for (int m = 0; m < 4; ++m) {
        const float ratio = rsc[ai * 128 + wr * 64 + m * 16 + fr];
#pragma unroll
        for (int bj = 0; bj < 2; ++bj)
#pragma unroll
          for (int n = 0; n < 2; ++n) acc[ai][bj][m][n] *= ratio;
      }
  }
  DEV void operator()(const f32x4 (&acc)[2][2][4][2], int pm, int pn, int wr, int wc, int fr, int fq, const float* rsc) const {
    const bool do_stat = MODE == 0 ? (pn >= 12 && pn < 15) : (MODE == 3 || MODE == 5);
    const int slot = MODE == 0 ? ((pn - 12) * 4 + wc) : (pn * 4 + wc);
    constexpr int SS = MODE == 0 ? 16 : 32;
    GLB_AS char* ob = (GLB_AS char*)uptr(out);
#pragma unroll
    for (int ai = 0; ai < 2; ++ai)
#pragma unroll
      for (int m = 0; m < 4; ++m) {
        const int rloc = ai * 128 + wr * 64 + m * 16 + fr, row = pm * 256 + rloc;
        float rs = (MODE == 0 && pn < 4) ? 0.08838834764831845f * 1.4426950408889634f : 1.f;
        if (MODE == 1) { const float* sp = st_in + (size_t)row * 16; const f32x4 a0 = *(const f32x4*)(sp), a1 = *(const f32x4*)(sp + 4);
          rs = rsqrtf(((a0[0] + a0[1]) + (a0[2] + a0[3]) + (a1[0] + a1[1]) + (a1[2] + a1[3])) * (1.f / 512.f) + EPS); }
        if (MODE == 2) { const f32x4 a0 = *(const f32x4*)(st_in + (size_t)row * 16 + 8); rs = rsqrtf(((a0[0] + a0[1]) + (a0[2] + a0[3])) * (1.f / 256.f) + EPS); }
        if (MODE == 3) rs = rsc[256 + rloc];
        f32x4 v[2][2];
#pragma unroll
        for (int bj = 0; bj < 2; ++bj)
#pragma unroll
          for (int n = 0; n < 2; ++n) v[bj][n] = acc[ai][bj][m][n] * rs;
        if (MODE == 0 || MODE == 3 || MODE == 5) {
          if (do_stat) {
            float s = 0.f;
#pragma unroll
            for (int bj = 0; bj < 2; ++bj)
#pragma unroll
              for (int n = 0; n < 2; ++n) s += (v[bj][n][0] * v[bj][n][0] + v[bj][n][1] * v[bj][n][1]) + (v[bj][n][2] * v[bj][n][2] + v[bj][n][3] * v[bj][n][3]);
            s += __shfl_xor(s, 16); s += __shfl_xor(s, 32);
            *(GLB_AS float*)((GLB_AS char*)uptr(st_out) + (unsigned)(row * SS + slot) * 4u) = s;
          }
        }
        u32x4 w[2];
#pragma unroll
        for (int bj = 0; bj < 2; ++bj) { w[bj][0] = cvtpk(v[bj][0][0], v[bj][0][1]); w[bj][1] = cvtpk(v[bj][0][2], v[bj][0][3]); w[bj][2] = cvtpk(v[bj][1][0], v[bj][1][1]); w[bj][3] = cvtpk(v[bj][1][2], v[bj][1][3]); }
        if (MODE == 0 && pn >= 4 && pn < 12) {
          GLB_AS char* hb_ = (GLB_AS char*)uptr(pn < 8 ? outK : outV);
#pragma unroll
          for (int bj = 0; bj < 2; ++bj) { const int hh = (pn & 3) * 2 + bj;
            *(GLB_AS u32x4*)(hb_ + (unsigned)((((row >> 11) * 8 + hh) * 2048 + (row & 2047)) * 128 + wc * 32 + 8 * fq) * 2u) = w[bj]; }
        } else if (MODE == 2) {
          const unsigned ho = (unsigned)((((row >> 11) * 8 + pn) * 2048 + (row & 2047)) * 128 + wc * 32 + 8 * fq) * 2u;
          *(GLB_AS u32x4*)((GLB_AS char*)uptr(outK) + ho) = w[0]; *(GLB_AS u32x4*)((GLB_AS char*)uptr(outV) + ho) = w[1];
        } else {
          const unsigned oo = (unsigned)(row * ldo + pn * 256 + wc * 32 + 8 * fq) * 2u;
          *(GLB_AS u32x4*)(ob + oo) = w[0]; *(GLB_AS u32x4*)(ob + oo + 256) = w[1];
        }
        asm volatile("" ::: "memory");
      }
  }
};

template <int MODE>
DEV void gemm_phase(char* shm, float* rowsc, const bf16_t* __restrict__ A, int lda, const bf16_t* __restrict__ Bt, int K, int nN, const Epi<MODE>& E,
                    float* halo = nullptr, float* HBp = nullptr, const float* conv_w = nullptr, const float* conv_b = nullptr) {
  constexpr int HALF = 128, HTB = HALF * 64 * 2;
  LDS_AS unsigned char* lds = (LDS_AS unsigned char*)shm;
  const int tid = opaque_tid(), wid = __builtin_amdgcn_readfirstlane(tid >> 6), lane = tid & 63, wr = wid >> 2, wc = wid & 3, fr = lane & 15, fq = lane >> 4;
  const int nt = K / 64;
  Sched S; S.nN = nN; S.nUnits = 32 * nN; S.G = gridDim.x; S.c = blockIdx.x;
  unsigned voffA[2], voffB[2];
#pragma unroll
  for (int i = 0; i < 2; ++i) { int R, C; stage_rc2(tid * 16 + i * 8192, R, C); const int Rb = (R & ~31) + perm32(R & 31);
    const int Ra = MODE == 4 ? ((R & 64) | ((R & 15) << 2) | ((R >> 4) & 3)) : R;
    voffA[i] = (unsigned)(Ra * lda + C) * 2u; voffB[i] = (unsigned)(Rb * K + C) * 2u; }
  const size_t kstep = 128;
  const size_t hstepA = (size_t)HALF * lda * 2, hstepB = (size_t)HALF * K * 2, tstepA = 2 * hstepA, tstepB = 2 * hstepB;
  const unsigned ldsw = (unsigned)wid * 1024u;
  const int aoff = lds_byte2(wr * 64 + fr, fq * 8), boff = lds_byte2(wc * 32 + fr, fq * 8);
  LDS_AS unsigned char* pa = lds + aoff; LDS_AS unsigned char* pb = lds + 4 * HTB + boff;
  asm volatile("" : "+v"(pa), "+v"(pb));
#define PG8_SA(b, h) (((b) * 2 + (h)) * HTB)
#define PG8_SB(b, h) ((4 + (b) * 2 + (h)) * HTB)
#define PG8_STAGE(bufoff, gbase, voff) do { const char* gb_ = uptr(gbase); _Pragma("unroll") for (int _i = 0; _i < 2; ++_i) \
        __builtin_amdgcn_global_load_lds((const unsigned*)(gb_ + (voff)[_i]), (LDS_AS unsigned*)(lds + (bufoff) + ldsw + _i * 8192), 16, 0, 0); } while (0)
#define PG8_LDA(dst, b, h) do { _Pragma("unroll") for (int m = 0; m < 4; ++m) _Pragma("unroll") for (int k = 0; k < 2; ++k) dst[m][k] = *(const LDS_AS bf16x8*)(pa + (PG8_SA(b, h) + m * 2048 + k * 1024)); } while (0)
#define PG8_LDB(dst, b, h) do { _Pragma("unroll") for (int n = 0; n < 2; ++n) _Pragma("unroll") for (int k = 0; k < 2; ++k) dst[n][k] = *(const LDS_AS bf16x8*)(pb + (PG8_SA(b, h) + n * 2048 + k * 1024)); } while (0)
#define PG8_MMA(ai, bj, At, Bt_) do { __builtin_amdgcn_s_setprio(1); _Pragma("unroll") for (int m = 0; m < 4; ++m) _Pragma("unroll") for (int n = 0; n < 2; ++n) _Pragma("unroll") for (int k = 0; k < 2; ++k) \
        acc[ai][bj][m][n] = __builtin_amdgcn_mfma_f32_16x16x32_bf16(Bt_[n][k], At[m][k], acc[ai][bj][m][n], 0, 0, 0); __builtin_amdgcn_s_setprio(0); } while (0)
#define PG8_WAIT_V(n) asm volatile("s_waitcnt vmcnt(" #n ")" ::: "memory")
#define PG8_WAIT_L(n) asm volatile("s_waitcnt lgkmcnt(" #n ")" ::: "memory")
#define PG8_BAR __builtin_amdgcn_s_barrier()
#define PG8_SCHED __builtin_amdgcn_sched_barrier(0)
  Unit cur, nxt; int ui = 0;
  if (!S.next(0, cur)) return;
  f32x4 acc[2][2][4][2];
#pragma unroll
  for (int a = 0; a < 2; ++a)
#pragma unroll
    for (int b = 0; b < 2; ++b)
#pragma unroll
      for (int m = 0; m < 4; ++m)
#pragma unroll
        for (int n = 0; n < 2; ++n) acc[a][b][m][n] = (f32x4){0.f, 0.f, 0.f, 0.f};
  bf16x8 At[4][2], B0[2][2], B1[2][2];
  const char* cA = (const char*)A + (size_t)cur.pm * tstepA; const char* cB = (const char*)Bt + (size_t)cur.pn * tstepB;
  if (MODE == 3) E.prep(rowsc, cur.pm * 256, tid);
  PG8_STAGE(PG8_SB(0, 0), cB, voffB); PG8_STAGE(PG8_SB(0, 1), cB + hstepB, voffB); PG8_STAGE(PG8_SA(0, 0), cA, voffA); PG8_STAGE(PG8_SA(0, 1), cA + hstepA, voffA);
  if (wr == 1) PG8_BAR;
  PG8_WAIT_V(2); PG8_BAR;
  PG8_STAGE(PG8_SB(1, 0), cB + kstep, voffB); PG8_STAGE(PG8_SA(1, 0), cA + kstep, voffA); PG8_STAGE(PG8_SB(1, 1), cB + hstepB + kstep, voffB);
  PG8_WAIT_V(6); PG8_BAR;
  for (;;) {
    const bool has_next = S.next(ui + 1, nxt);
    const char* nA = has_next ? (const char*)A + (size_t)nxt.pm * tstepA : cA; const char* nB = has_next ? (const char*)Bt + (size_t)nxt.pn * tstepB : cB;
    const float* rsc = rowsc + (ui & 1) * 512;
    for (int t = 0; t < nt; t += 2) {
      const bool last = (t == nt - 2);
      const char* a1 = cA + (size_t)(t + 1) * kstep;
      const char* a2 = last ? nA : cA + (size_t)(t + 2) * kstep; const char* b2 = last ? nB : cB + (size_t)(t + 2) * kstep;
      const char* a3 = a2 + kstep; const char* b3 = b2 + kstep;
      if (MODE == 3) { if (t == 16) E.hook(acc, rsc, wr, fr); }
      PG8_LDB(B0, 0, 0); PG8_LDB(B1, 0, 1); PG8_SCHED; PG8_LDA(At, 0, 0); PG8_STAGE(PG8_SA(1, 1), a1 + hstepA, voffA);
      PG8_WAIT_V(8); PG8_WAIT_L(0); PG8_BAR; PG8_MMA(0, 0, At, B0); PG8_MMA(0, 1, At, B1); PG8_BAR; PG8_SCHED;
      PG8_LDA(At, 0, 1); PG8_STAGE(PG8_SB(0, 0), b2, voffB); PG8_STAGE(PG8_SB(0, 1), b2 + hstepB, voffB); PG8_STAGE(PG8_SA(0, 0), a2, voffA);
      PG8_WAIT_V(8); PG8_WAIT_L(0); PG8_BAR; PG8_MMA(1, 0, At, B0); PG8_MMA(1, 1, At, B1); PG8_BAR; PG8_SCHED;
      PG8_LDB(B0, 1, 0); PG8_LDB(B1, 1, 1); PG8_SCHED; PG8_LDA(At, 1, 0); PG8_STAGE(PG8_SA(0, 1), a2 + hstepA, voffA);
      PG8_WAIT_V(8); PG8_WAIT_L(0); PG8_BAR; PG8_MMA(0, 0, At, B0); PG8_MMA(0, 1, At, B1); PG8_BAR; PG8_SCHED;
      PG8_LDA(At, 1, 1); PG8_STAGE(PG8_SB(1, 0), b3, voffB); PG8_STAGE(PG8_SB(1, 1), b3 + hstepB, voffB); PG8_STAGE(PG8_SA(1, 0), a3, voffA);
      PG8_WAIT_V(8); PG8_WAIT_L(0); PG8_BAR; PG8_MMA(1, 0, At, B0); PG8_MMA(1, 1, At, B1); PG8_BAR; PG8_SCHED;
    }
    if (wr == 0) PG8_BAR;
    { const int t2 = opaque_tid();
      if (MODE == 4) epi_up(acc, cur.pm, cur.pn, (t2 >> 8) & 1, (t2 >> 6) & 3, t2 & 15, (t2 >> 4) & 3, halo, E.out, HBp, conv_w, conv_b);
      else E(acc, cur.pm, cur.pn, (t2 >> 8) & 1, (t2 >> 6) & 3, t2 & 15, (t2 >> 4) & 3, rsc); }
    if (!has_next) break;
#pragma unroll
    for (int a = 0; a < 2; ++a)
#pragma unroll
      for (int b = 0; b < 2; ++b)
#pragma unroll
        for (int m = 0; m < 4; ++m)
#pragma unroll
          for (int n = 0; n < 2; ++n) acc[a][b][m][n] = (f32x4){0.f, 0.f, 0.f, 0.f};
    cur = nxt; cA = nA; cB = nB; ++ui;
    if (MODE == 3) E.prep(rowsc + (ui & 1) * 512, cur.pm * 256, tid);
    if (wr == 1) PG8_BAR;
  }
  PG8_WAIT_V(0);
  PG8_BAR;
#undef PG8_SA
#undef PG8_SB
#undef PG8_STAGE
#undef PG8_LDA
#undef PG8_LDB
#undef PG8_MMA
#undef PG8_WAIT_V
#undef PG8_WAIT_L
#undef PG8_BAR
#undef PG8_SCHED
}

DEV int v_st(int k, int c) { const int kk = (k & ~0xC) | ((k & 4) << 1) | ((k & 8) >> 1); return ((kk >> 3) * 4 + (c >> 5)) * 512 + ((kk & 7) * 32 + (c & 31)) * 2; }
DEV int v_rd_base(int lane) { return ((lane & 3) << 3) | (((lane >> 2) & 3) << 6) | (((lane >> 4) & 1) << 5) | (((lane >> 5) & 1) << 8); }
constexpr int v_rd_off(int d0, int ks, int half) { return d0 * 512 + ks * 4096 + half * 2048; }
template <int OFF> DEV s16x4 tr_read(int vb) { s16x4 r; asm volatile("ds_read_b64_tr_b16 %0, %1 offset:%2" : "=&v"(r) : "v"(vb), "i"(OFF) : "memory"); return r; }
template <int D0> DEV void pv_one(f32x16& od, int vb, bf16x8 pa0, bf16x8 pa1, bf16x8 pa2, bf16x8 pa3) {
  const s16x4 l0 = tr_read<v_rd_off(D0, 0, 0)>(vb), h0 = tr_read<v_rd_off(D0, 0, 1)>(vb), l1 = tr_read<v_rd_off(D0, 1, 0)>(vb), h1 = tr_read<v_rd_off(D0, 1, 1)>(vb);
  const s16x4 l2 = tr_read<v_rd_off(D0, 2, 0)>(vb), h2 = tr_read<v_rd_off(D0, 2, 1)>(vb), l3 = tr_read<v_rd_off(D0, 3, 0)>(vb), h3 = tr_read<v_rd_off(D0, 3, 1)>(vb);
  asm volatile("s_waitcnt lgkmcnt(0)" ::: "memory"); SBAR();
#define PKV(L, H) (bf16x8){L[0], L[1], L[2], L[3], H[0], H[1], H[2], H[3]}
  od = __builtin_amdgcn_mfma_f32_32x32x16_bf16(pa0, PKV(l0, h0), od, 0, 0, 0);
  od = __builtin_amdgcn_mfma_f32_32x32x16_bf16(pa1, PKV(l1, h1), od, 0, 0, 0);
  od = __builtin_amdgcn_mfma_f32_32x32x16_bf16(pa2, PKV(l2, h2), od, 0, 0, 0);
  od = __builtin_amdgcn_mfma_f32_32x32x16_bf16(pa3, PKV(l3, h3), od, 0, 0, 0);
#undef PKV
}
#define PK4(P, BASE, OUT) do { unsigned a0_ = cvtpk(P[BASE + 0], P[BASE + 1]), a1_ = cvtpk(P[BASE + 2], P[BASE + 3]);   \
    unsigned b0_ = cvtpk(P[BASE + 4], P[BASE + 5]), b1_ = cvtpk(P[BASE + 6], P[BASE + 7]);                              \
    auto r0_ = __builtin_amdgcn_permlane32_swap(a0_, b0_, false, false); auto r1_ = __builtin_amdgcn_permlane32_swap(a1_, b1_, false, false); \
    u32x4 w_ = {r0_[0], r1_[0], r0_[1], r1_[1]}; OUT = *reinterpret_cast<bf16x8*>(&w_); } while (0)

DEV void sb_half(f32x16& P, float& run, bool diag, int key0, int qrow, int hi) {
  constexpr float C = 0.08838834764831845f * 1.4426950408889634f;
#pragma unroll
  for (int r = 0; r < 16; ++r) P[r] = fmaxf(P[r], -100.f);
  if (diag) {
#pragma unroll
    for (int r = 0; r < 16; ++r) { if (key0 + crow(r, hi) >= qrow) P[r] = -100.f; }
  }
  f32x16 L;
#pragma unroll
  for (int r = 0; r < 16; ++r) { const float em = __builtin_amdgcn_exp2f(-P[r]); const float be = __builtin_amdgcn_rcpf(1.f + em); P[r] = be; L[r] = em * be; }
#pragma unroll
  for (int g = 3; g >= 0; --g) {
    const float gs = (L[4 * g] * L[4 * g + 1]) * (L[4 * g + 2] * L[4 * g + 3]);
    auto rr = __builtin_amdgcn_permlane32_swap(__float_as_uint(gs), __float_as_uint(gs), false, false);
    const float lo = __uint_as_float(rr[0]), hv = __uint_as_float(rr[1]);
    const float e3 = run * (hi == 0 ? hv : 1.f), e2 = e3 * L[4 * g + 3], e1 = e2 * L[4 * g + 2], e0 = e1 * L[4 * g + 1];
    run *= lo * hv;
    P[4 * g + 3] *= e3; P[4 * g + 2] *= e2; P[4 * g + 1] *= e1; P[4 * g + 0] *= e0;
  }
}
DEV void sb_tile(f32x16& p0, f32x16& p1, float& carry, bool diag, int kt0, int qrow, int hi) {
  sb_half(p1, carry, diag, kt0 + 32, qrow, hi);
  sb_half(p0, carry, diag, kt0, qrow, hi);
}

template <bool MLA>
DEV void attn_unit(char* lds, const bf16_t* __restrict__ Qb, int ldq, const bf16_t* __restrict__ Kb, int ldk, const bf16_t* __restrict__ Krb, int ldkr,
                   const bf16_t* __restrict__ Vb, int ldv, bf16_t* __restrict__ Ob, int ldo, float* __restrict__ statb, int qb, const float* __restrict__ cosb, const float* __restrict__ sinb) {
  constexpr int DQ = MLA ? 192 : 128, ND = DQ / 16, ROWB = DQ * 2, SHMK = 64 * ROWB, SHMV = 16384, VOFF = 2 * SHMK, SCR = VOFF + 3 * SHMV;
#define KSWZ(row, colB) ((row) * ROWB + ((colB) ^ (((row) & 7) << 4)))
  const int tid = opaque_tid(), wid = tid >> 6, lane = tid & 63, r32 = lane & 31, hi = lane >> 5;
  float* al_l = (float*)(lds + SCR + wid * 256); float* li_l = al_l + 32;
  char* qlds = lds + SCR + 2048 + wid * 4096 + lane * 16;
  const int q0w = 256 * qb + 32 * wid, qrow = q0w + r32;
  bf16x8 qr[ND];
  { const bf16_t* Qw = Qb + (size_t)qrow * ldq + hi * 8;
#pragma unroll
    for (int d0 = 0; d0 < ND; ++d0) qr[d0] = *(const bf16x8*)(Qw + d0 * 16); }
  if (MLA) {
#pragma unroll
    for (int dd = 0; dd < 2; ++dd) {
      const float* cp = cosb + (size_t)qrow * 32 + dd * 16 + hi * 8; const float* sp = sinb + (size_t)qrow * 32 + dd * 16 + hi * 8;
      const f32x4 c0 = *(const f32x4*)cp, c1 = *(const f32x4*)(cp + 4), s0 = *(const f32x4*)sp, s1 = *(const f32x4*)(sp + 4);
      const u32x4 a = __builtin_bit_cast(u32x4, qr[ND - 4 + dd]), b = __builtin_bit_cast(u32x4, qr[ND - 2 + dd]);
      u32x4 ya, yb;
#pragma unroll
      for (int q = 0; q < 4; ++q) {
        const float cl = q < 2 ? c0[2 * q] : c1[2 * q - 4], ch = q < 2 ? c0[2 * q + 1] : c1[2 * q - 3];
        const float sl = q < 2 ? s0[2 * q] : s1[2 * q - 4], sh = q < 2 ? s0[2 * q + 1] : s1[2 * q - 3];
        const float x1l = bf_lo(a[q]), x1h = bf_hi(a[q]), x2l = bf_lo(b[q]), x2h = bf_hi(b[q]);
        ya[q] = cvtpk(x1l * cl - x2l * sl, x1h * ch - x2h * sh); yb[q] = cvtpk(x1l * sl + x2l * cl, x1h * sh + x2h * ch);
      }
      qr[ND - 4 + dd] = __builtin_bit_cast(bf16x8, ya); qr[ND - 2 + dd] = __builtin_bit_cast(bf16x8, yb);
    }
#pragma unroll
    for (int d = 0; d < 4; ++d) *(bf16x8*)(qlds + d * 1024) = qr[ND - 4 + d];
  }
  f32x16 o[4];
#pragma unroll
  for (int d = 0; d < 4; ++d)
#pragma unroll
    for (int r = 0; r < 16; ++r) o[d][r] = 0.f;
  float carry = 1.f, m_reg = -1e30f, l_reg = 0.f;
  const int NT = 4 * qb + 4, jmax = 4 * qb + (wid >> 1);
  const int sr = tid >> 4, sc = (tid & 15) * 8, vst0 = v_st(sr, sc), vst1 = v_st(32 + sr, sc), krr = tid >> 3, krc = (tid & 7) * 8;
  const int vb0 = (int)(unsigned)(uintptr_t)(lds + VOFF) + v_rd_base(lane);
  bf16x8 ks0, ks1, vs0, vs1, kx;
#define A_LOAD(jt) do { const int kt0_ = (jt) * 64; \
    ks0 = *(const bf16x8*)(Kb + (size_t)(kt0_ + sr) * ldk + sc); ks1 = *(const bf16x8*)(Kb + (size_t)(kt0_ + 32 + sr) * ldk + sc); \
    vs0 = *(const bf16x8*)(Vb + (size_t)(kt0_ + sr) * ldv + sc); vs1 = *(const bf16x8*)(Vb + (size_t)(kt0_ + 32 + sr) * ldv + sc); \
    if (MLA) kx = *(const bf16x8*)(Krb + (size_t)(kt0_ + krr) * ldkr + krc); SBAR(); } while (0)
#define A_WRITE(kb, vslot) do { char* base_ = lds + (kb) * SHMK; char* vbase_ = lds + VOFF + (vslot) * SHMV; \
    *(bf16x8*)(base_ + KSWZ(sr, sc * 2)) = ks0; *(bf16x8*)(base_ + KSWZ(32 + sr, sc * 2)) = ks1; \
    *(bf16x8*)(vbase_ + vst0) = vs0; *(bf16x8*)(vbase_ + vst1) = vs1; \
    if (MLA) *(bf16x8*)(base_ + KSWZ(krr, (128 + krc) * 2)) = kx; } while (0)
#define A_PV(vslot) do { const int vb_ = vb0 + (vslot) * SHMV; \
    pv_one<0>(o[0], vb_, pa0, pa1, pa2, pa3); pv_one<1>(o[1], vb_, pa0, pa1, pa2, pa3); pv_one<2>(o[2], vb_, pa0, pa1, pa2, pa3); pv_one<3>(o[3], vb_, pa0, pa1, pa2, pa3); } while (0)
  const bool late = wid >= 4; bool pend = false;
  bool done_w = false; int* dflag = (int*)(lds + SCR + 2048);
  bf16x8 pa0, pa1, pa2, pa3;
  A_LOAD(NT - 1); A_WRITE(0, 0); A_LOAD(NT - 2); __syncthreads();
  int vs = 0;
  for (int i = 0; i < NT; ++i) {
    const int jt = NT - 1 - i, cur = i & 1, vnext = vs == 2 ? 0 : vs + 1, vprev = vs == 0 ? 2 : vs - 1;
    if (i + 1 < NT) A_WRITE(cur ^ 1, vnext);
    if (late && pend) { A_PV(vprev); pend = false; }
    if (jt > jmax || done_w) { if (i + 2 < NT) A_LOAD(jt - 2); }
    else {
      const char* Kl = lds + cur * SHMK;
      f32x16 p0, p1;
#pragma unroll
      for (int r = 0; r < 16; ++r) { p0[r] = 0.f; p1[r] = 0.f; }
      {
        bf16x8 kb0[4], kb1[4], qb0[2], qb1[2];
#define QK_LOAD(KB, QB, bt) do { _Pragma("unroll") for (int u_ = 0; u_ < 2; ++u_) { const int d0_ = 2 * (bt) + u_; const int cb_ = (d0_ * 16 + hi * 8) * 2; \
          KB[2 * u_] = *(const bf16x8*)(Kl + KSWZ(r32, cb_)); KB[2 * u_ + 1] = *(const bf16x8*)(Kl + KSWZ(32 + r32, cb_)); \
          if (MLA && d0_ >= 8) QB[u_] = *(const bf16x8*)(qlds + (d0_ - 8) * 1024); else QB[u_] = qr[d0_ < 8 ? d0_ : 0]; } } while (0)
#define QK_MMA(KB, QB) do { _Pragma("unroll") for (int u_ = 0; u_ < 2; ++u_) { \
          p0 = __builtin_amdgcn_mfma_f32_32x32x16_bf16(KB[2 * u_], QB[u_], p0, 0, 0, 0); p1 = __builtin_amdgcn_mfma_f32_32x32x16_bf16(KB[2 * u_ + 1], QB[u_], p1, 0, 0, 0); } } while (0)
        QK_LOAD(kb0, qb0, 0); SBAR();
#pragma unroll
        for (int bt = 0; bt < ND / 2; bt += 2) {
          QK_LOAD(kb1, qb1, bt + 1); SBAR();
          QK_MMA(kb0, qb0); SBAR();
          if (bt + 2 < ND / 2) { QK_LOAD(kb0, qb0, bt + 2); SBAR(); }
          QK_MMA(kb1, qb1); SBAR();
        }
#undef QK_LOAD
#undef QK_MMA
      }
      if (MLA) {
        constexpr float C2 = 0.07216878364870323f * 1.4426950408889634f;
        float pmax = p0[0];
#pragma unroll
        for (int r = 1; r < 16; ++r) pmax = fmaxf(pmax, p0[r]);
#pragma unroll
        for (int r = 0; r < 16; ++r) pmax = fmaxf(pmax, p1[r]);
        { auto rr = __builtin_amdgcn_permlane32_swap(__float_as_uint(pmax), __float_as_uint(pmax), false, false);
          pmax = fmaxf(__uint_as_float(rr[0]), __uint_as_float(rr[1])); }
        float mn, alpha;
        if (__all(pmax - m_reg <= 8.f / 0.07216878364870323f)) { mn = m_reg; alpha = 1.f; }
        else { mn = fmaxf(m_reg, pmax); alpha = __builtin_amdgcn_exp2f((m_reg - mn) * C2); m_reg = mn; }
        const float mnC = -mn * C2;
        float ps = 0.f;
#pragma unroll
        for (int r = 0; r < 16; ++r) { p0[r] = __builtin_amdgcn_exp2f(fmaf(p0[r], C2, mnC)); p1[r] = __builtin_amdgcn_exp2f(fmaf(p1[r], C2, mnC)); ps += p0[r] + p1[r]; }
        { auto rr = __builtin_amdgcn_permlane32_swap(__float_as_uint(ps), __float_as_uint(ps), false, false);
          ps = __uint_as_float(rr[0]) + __uint_as_float(rr[1]); }
        l_reg = l_reg * alpha + ps;
        if (__any(alpha < 1.f)) {
          if (hi == 0) al_l[r32] = alpha;
          asm volatile("s_waitcnt lgkmcnt(0)" ::: "memory");
#pragma unroll
          for (int r = 0; r < 16; ++r) { const float a = al_l[crow(r, hi)];
#pragma unroll
            for (int d = 0; d < 4; ++d) o[d][r] *= a; }
        }
      } else {
        sb_tile(p0, p1, carry, jt == jmax, jt * 64, qrow, hi);
        done_w = __all(carry < 1e-18f);
      }
      PK4(p0, 0, pa0); PK4(p0, 8, pa1); PK4(p1, 0, pa2); PK4(p1, 8, pa3);
      if (i + 2 < NT) A_LOAD(jt - 2);
      if (late) pend = true; else A_PV(vs);
    }
    if (!MLA) { if (lane == 0) dflag[(i & 1) * 8 + wid] = done_w ? 1 : 0; }
    __syncthreads();
    vs = vnext;
    if (!MLA) {
      const int* df = dflag + (i & 1) * 8;
      if ((df[0] & df[1] & df[2] & df[3] & df[4] & df[5] & df[6] & df[7]) != 0) break;
    }
  }
  if (late && pend) { const int vlast = vs == 0 ? 2 : vs - 1; A_PV(vlast); }
  __syncthreads();
  if (MLA) {
    if (hi == 0) li_l[r32] = l_reg;
    asm volatile("s_waitcnt lgkmcnt(0)" ::: "memory");
#pragma unroll
    for (int r = 0; r < 16; ++r) { const float rl = __builtin_amdgcn_rcpf(li_l[crow(r, hi)]);
#pragma unroll
      for (int d = 0; d < 4; ++d) o[d][r] *= rl; }
  }
#pragma unroll
  for (int r = 0; r < 16; ++r) {
    const int orow = q0w + crow(r, hi);
    float s = (o[0][r] * o[0][r] + o[1][r] * o[1][r]) + (o[2][r] * o[2][r] + o[3][r] * o[3][r]);
    s += __shfl_xor(s, 16); s += __shfl_xor(s, 8); s += __shfl_xor(s, 4); s += __shfl_xor(s, 2); s += __shfl_xor(s, 1);
    if (r32 == 0) statb[(size_t)orow * 16] = s;
#pragma unroll
    for (int d = 0; d < 4; ++d) Ob[(size_t)orow * ldo + d * 32 + r32] = (bf16_t)(cvtpk(o[d][r], o[d][r]) & 0xffffu);
  }
#undef A_LOAD
#undef A_WRITE
#undef A_PV
#undef KSWZ
}

struct TrTile { const float* src; bf16_t* dst; const float* g; int K, N, k0, n0, perm; };
DEV TrTile tr_decode(const Params& p, char* ws, int ti) {
  TrTile t; t.g = nullptr; t.perm = 0; int ntn, loc;
  if (ti < 512) { t.src = p.w_in; t.dst = (bf16_t*)(ws + OFF_WIN); t.K = 2048; t.N = INC; ntn = 16; loc = ti; }
  else if (ti < 560) { t.src = p.w_uq; t.dst = (bf16_t*)(ws + OFF_WUQ); t.g = p.g_cq; t.K = 512; t.N = 1536; ntn = 6; loc = ti - 512; }
  else if (ti < 592) { t.src = p.w_ukv; t.dst = (bf16_t*)(ws + OFF_WUKV); t.g = p.g_ckv; t.K = 256; t.N = 2048; ntn = 8; loc = ti - 560; }
  else if (ti < 848) { t.src = p.w_o; t.dst = (bf16_t*)(ws + OFF_WO); t.K = 2048; t.N = 2048; ntn = 8; loc = ti - 592; }
  else if (ti < 2256) { t.src = p.w_up; t.dst = (bf16_t*)(ws + OFF_WUP); t.K = 2048; t.N = DFF2; ntn = 44; loc = ti - 848; t.perm = 1; }
  else { t.src = p.w_down; t.dst = (bf16_t*)(ws + OFF_WDN); t.K = DFF; t.N = 2048; ntn = 8; loc = ti - 2256; }
  const int kt = loc / ntn; t.k0 = kt * 64; t.n0 = (loc % ntn) * 256;
  if (ti >= 592 && ti < 848) t.g = (kt < 16) ? p.g_out_sb : (p.g_out_mla - 1024);
  return t;
}
DEV void tr_load(const TrTile& t, f32x4 (&v)[8], int tid) {
  const int n4 = (tid & 63) * 4, kr = tid >> 6;
#pragma unroll
  for (int i = 0; i < 8; ++i) {
    const int k = kr + 8 * i; v[i] = (f32x4){0.f, 0.f, 0.f, 0.f};
    if (t.n0 + n4 < t.N) v[i] = __builtin_nontemporal_load((const f32x4*)(t.src + (size_t)(t.k0 + k) * t.N + t.n0 + n4));
  }
}
DEV void tr_to_lds(const TrTile& t, const f32x4 (&v)[8], float* tile, int tid) {
  const int n4 = (tid & 63) * 4, kr = tid >> 6;
#pragma unroll
  for (int i = 0; i < 8; ++i) { const int k = kr + 8 * i; f32x4 x = v[i]; if (t.g) x *= t.g[t.k0 + k]; *(f32x4*)(tile + k * 260 + n4) = x; }
}
DEV void tr_store(const TrTile& t, const float* tile, int tid) {
  const int n = tid >> 1, kh = (tid & 1) * 32;
#pragma unroll
  for (int q = 0; q < 4; ++q) {
    u32x4 w;
#pragma unroll
    for (int j = 0; j < 4; ++j) w[j] = cvtpk(tile[(kh + 8 * q + 2 * j) * 260 + n], tile[(kh + 8 * q + 2 * j + 1) * 260 + n]);
    int dn = t.n0 + n;
    if (t.perm) { const int bj = dn >= DFF ? 1 : 0, ch = dn - bj * DFF; dn = (ch >> 7) * 256 + bj * 128 + (ch & 127); }
    *(u32x4*)(t.dst + (size_t)dn * t.K + t.k0 + kh + 8 * q) = w;
  }
}


DEV unsigned long long probe_begin(int k) { return (k == AMP_PHASE) ? __builtin_amdgcn_s_memrealtime() : 0ull; }
DEV void probe_end(int k, unsigned long long t0, const XcdBarrier& xb) {
  if (k == AMP_PHASE) {
    if (blockIdx.x == 0 && threadIdx.x == 0) { const unsigned long long t1 = __builtin_amdgcn_s_memrealtime(); while (__builtin_amdgcn_s_memrealtime() - t1 < (t1 - t0)) __builtin_amdgcn_s_sleep(4); }
    xcd_barrier(xb);
  }
}
__global__ void __launch_bounds__(512, 2) fwd_kernel(Params p) {
  __shared__ __attribute__((aligned(1024))) char shm[135168];
  __shared__ int s_unit;
  __shared__ float rowsc[1024];
  __shared__ __attribute__((aligned(16))) float halo[2048];
  __shared__ uint4 xb_words;
  cg::grid_group grid = cg::this_grid();
  if (threadIdx.x == 0) xb_words = make_uint4(0u, 0u, 0u, 0u);
  __syncthreads();
  unsigned* BAR = (unsigned*)(p.ws + OFF_CNT);
  const XcdBarrier xb = xcd_barrier_post(BAR, (volatile LDS_AS unsigned*)&xb_words);
  if (p.ws == nullptr) grid.sync();
  const int bid = blockIdx.x, nblk = gridDim.x;
  char* ws = p.ws;
  bf16_t* WIN = (bf16_t*)(ws + OFF_WIN); bf16_t* WUQ = (bf16_t*)(ws + OFF_WUQ); bf16_t* WUKV = (bf16_t*)(ws + OFF_WUKV); bf16_t* WO = (bf16_t*)(ws + OFF_WO);
  bf16_t* H = (bf16_t*)(ws + OFF_H); bf16_t* Y = (bf16_t*)(ws + OFF_Y); bf16_t* ACT = (bf16_t*)(ws + OFF_ACT); bf16_t* WUP = (bf16_t*)(ws + OFF_WUP);
  bf16_t* WDN = (bf16_t*)(ws + OFF_WDN); bf16_t* PROJ = (bf16_t*)(ws + OFF_PROJ); bf16_t* Q = (bf16_t*)(ws + OFF_Q);
  bf16_t* KV = (bf16_t*)(ws + OFF_KV); bf16_t* O = (bf16_t*)(ws + OFF_O); bf16_t* Y2 = (bf16_t*)(ws + OFF_Y2);
  float* COS = (float*)(ws + OFF_COS); float* SIN = (float*)(ws + OFF_SIN); float* STC = (float*)(ws + OFF_STC); float* STO = (float*)(ws + OFF_STO);
  float* STY = (float*)(ws + OFF_STY); float* STY2 = (float*)(ws + OFF_STY2); bf16_t* KR = (bf16_t*)(ws + OFF_KR); bf16_t* KSB = (bf16_t*)(ws + OFF_Y); bf16_t* VSB = KSB + (size_t)T_ * 1024; bf16_t* KM = KV; bf16_t* VM = KV + (size_t)T_ * 1024; float* HB = (float*)(ws + OFF_HB); unsigned* CNT = BAR + XB_QCNT;

  const unsigned long long pt0_ = probe_begin(0);
  PH(0) {
    const int tid = opaque_tid(), wid = tid >> 6, lane = tid & 63;
    {
      float* tile = (float*)shm;
      f32x4 v[8]; TrTile tt;
      int ti = bid;
      if (ti < 592) { tt = tr_decode(p, ws, ti); tr_load(tt, v, tid); }
      for (; ti < 592; ti += nblk) {
        tr_to_lds(tt, v, tile, tid);
        __syncthreads();
        const TrTile cur = tt;
        if (ti + nblk < 592) { tt = tr_decode(p, ws, ti + nblk); tr_load(tt, v, tid); }
        tr_store(cur, tile, tid);
        __syncthreads();
      }
    }
    for (int i = 0; i < 4; i += 2) {
      const int tb = bid * 8 + wid + i * 2048;
      f32x4 v[2][8]; float ss[2] = {0.f, 0.f};
#pragma unroll
      for (int q = 0; q < 2; ++q)
#pragma unroll
        for (int j = 0; j < 8; ++j) { v[q][j] = __builtin_nontemporal_load((const f32x4*)(p.x + (size_t)(tb + q * 2048) * DM + j * 256 + lane * 4));
          ss[q] += (v[q][j][0] * v[q][j][0] + v[q][j][1] * v[q][j][1]) + (v[q][j][2] * v[q][j][2] + v[q][j][3] * v[q][j][3]); }
      float r[2];
#pragma unroll
      for (int q = 0; q < 2; ++q) r[q] = rsqrtf(wave_sum(ss[q]) * (1.f / 2048.f) + EPS);
#pragma unroll
      for (int j = 0; j < 8; ++j) { const f32x4 g4 = *(const f32x4*)(p.g_attn_pre + j * 256 + lane * 4);
#pragma unroll
        for (int q = 0; q < 2; ++q) { const f32x4 y = v[q][j] * r[q] * g4;
          u32x2 w; w[0] = cvtpk(y[0], y[1]); w[1] = cvtpk(y[2], y[3]); *(u32x2*)(H + (size_t)(tb + q * 2048) * DM + j * 256 + lane * 4) = w; } }
    }
    for (int idx = bid * 512 + tid; idx < T_ * 32; idx += nblk * 512) {
      const int t = idx >> 5, fi = idx & 31;
      const float inv = exp2f(-(float)fi * (13.287712379549449f / 32.f));
      const float ang = (float)p.pos[t] * inv;
      double rev = (double)ang * 0.15915494309189535; rev -= floor(rev);
      const float rf = (float)rev;
      COS[idx] = __builtin_amdgcn_cosf(rf); SIN[idx] = __builtin_amdgcn_sinf(rf);
    }
  }
  xcd_barrier(xb);
  probe_end(0, pt0_, xb);
  for (int es_ = 0; es_ < EXTRA_SYNC; ++es_) xcd_barrier(xb);
  const unsigned long long pt1_ = probe_begin(1);
  PH(1) { Epi<0> e; e.outK = KSB; e.outV = VSB; e.out = PROJ; e.ldo = INP; e.st_in = nullptr; e.st_out = STC;
    gemm_phase<0>(shm, rowsc, H, DM, WIN, 2048, 16, e); }
  xcd_barrier(xb);
  probe_end(1, pt1_, xb);
  const unsigned long long pt2_ = probe_begin(2);
  PH(2) {
    for (int idx = bid * 512 + opaque_tid(); idx < T_ * 32; idx += nblk * 512) {
      const int t = idx >> 5, i = idx & 31;
      const float x1 = __uint_as_float((unsigned)PROJ[(size_t)t * INP + 3840 + i] << 16), x2 = __uint_as_float((unsigned)PROJ[(size_t)t * INP + 3872 + i] << 16);
      const float c = COS[idx], sn = SIN[idx];
      KR[(size_t)t * 64 + i] = (bf16_t)(cvtpk(x1 * c - x2 * sn, 0.f) & 0xffffu); KR[(size_t)t * 64 + 32 + i] = (bf16_t)(cvtpk(x1 * sn + x2 * c, 0.f) & 0xffffu);
    }
    Epi<1> e; e.out = Q; e.ldo = 1536; e.st_in = STC; e.st_out = nullptr;
    gemm_phase<1>(shm, rowsc, PROJ + 3072, INP, WUQ, 512, 6, e);
    Epi<2> e2; e2.outK = KM; e2.outV = VM; e2.out = KV; e2.ldo = 2048; e2.st_in = STC; e2.st_out = nullptr;
    gemm_phase<2>(shm, rowsc, PROJ + 3584, INP, WUKV, 256, 8, e2); }
  xcd_barrier(xb);
  probe_end(2, pt2_, xb);
  const unsigned long long pt3_ = probe_begin(3);
  PH(3) for (int first_ = 1;; first_ = 0) {
    const int tid = opaque_tid();
    int u;
    if (first_) u = bid;
    else {
      if (tid == 0) s_unit = 256 + (int)atomicAdd(CNT, 1u);
      __syncthreads();
      u = s_unit;
      __syncthreads();
    }
    if (u >= 512 + 416) break;
    if (u >= 512) {
      float* tile = (float*)shm; f32x4 v[8]; TrTile tt;
      int ti = 592 + 4 * (u - 512); const int te = ti + 4;
      tt = tr_decode(p, ws, ti); tr_load(tt, v, tid);
      for (; ti < te; ++ti) {
        tr_to_lds(tt, v, tile, tid);
        __syncthreads();
        const TrTile cur = tt;
        if (ti + 1 < te) { tt = tr_decode(p, ws, ti + 1); tr_load(tt, v, tid); }
        tr_store(cur, tile, tid);
        __syncthreads();
      }
      continue;
    }
    const int mla = u < 256 ? 1 : 0, v_ = u & 255, qb = 7 - (v_ >> 5), b = (v_ & 31) >> 3, h = v_ & 7;
    const size_t r0 = (size_t)b * SEQ;
    if (mla) attn_unit<true>(shm, Q + r0 * 1536 + h * 192, 1536, KM + ((size_t)(b * 8 + h) * 2048) * 128, 128, KR + r0 * 64, 64, VM + ((size_t)(b * 8 + h) * 2048) * 128, 128,
                             O + r0 * 2048 + 1024 + h * 128, 2048, STO + r0 * 16 + 8 + h, qb, COS + r0 * 32, SIN + r0 * 32);
    else attn_unit<false>(shm, PROJ + r0 * INP + h * 128, INP, KSB + ((size_t)(b * 8 + h) * 2048) * 128, 128, nullptr, 0, VSB + ((size_t)(b * 8 + h) * 2048) * 128, 128,
                          O + r0 * 2048 + h * 128, 2048, STO + r0 * 16 + h, qb, nullptr, nullptr);
  }
  xcd_barrier(xb);
  probe_end(3, pt3_, xb);
  const unsigned long long pt4_ = probe_begin(4);
  PH(4) { Epi<3> e; e.out = Y; e.ldo = 2048; e.st_in = STO; e.st_out = STY;
    gemm_phase<3>(shm, rowsc, O, 2048, WO, 2048, 8, e); }
  xcd_barrier(xb);
  probe_end(4, pt4_, xb);
  const unsigned long long pt5_ = probe_begin(5);
  PH(5) for (int i = 0; i < 4; i += 2) {
    const int tid = opaque_tid(), wid = tid >> 6, lane = tid & 63;
    const int tb = bid * 8 + wid + i * 2048;
    float r[2]; f32x4 x1[2][4][2]; float ss[2];
#pragma unroll
    for (int q = 0; q < 2; ++q) {
      float s = STY[(size_t)(tb + q * 2048) * 32 + (lane & 31)];
      s += __shfl_xor(s, 16); s += __shfl_xor(s, 8); s += __shfl_xor(s, 4); s += __shfl_xor(s, 2); s += __shfl_xor(s, 1);
      r[q] = rsqrtf(s * (1.f / 2048.f) + EPS); ss[q] = 0.f;
    }
#pragma unroll
    for (int j = 0; j < 4; ++j) {
      const int c = j * 512 + lane * 8;
      const f32x4 ga = *(const f32x4*)(p.g_attn_post + c), gb = *(const f32x4*)(p.g_attn_post + c + 4);
#pragma unroll
      for (int q = 0; q < 2; ++q) {
        const size_t ro = (size_t)(tb + q * 2048) * DM + c;
        const u32x4 yw = *(const u32x4*)(Y + ro);
        const f32x4 xa = __builtin_nontemporal_load((const f32x4*)(p.x + ro)), xb2 = __builtin_nontemporal_load((const f32x4*)(p.x + ro + 4));
        const f32x4 ya = {bf_lo(yw[0]), bf_hi(yw[0]), bf_lo(yw[1]), bf_hi(yw[1])}, yb = {bf_lo(yw[2]), bf_hi(yw[2]), bf_lo(yw[3]), bf_hi(yw[3])};
        x1[q][j][0] = xa + ya * r[q] * ga; x1[q][j][1] = xb2 + yb * r[q] * gb;
        { u32x4 xw; xw[0] = cvtpk(x1[q][j][0][0], x1[q][j][0][1]); xw[1] = cvtpk(x1[q][j][0][2], x1[q][j][0][3]); xw[2] = cvtpk(x1[q][j][1][0], x1[q][j][1][1]); xw[3] = cvtpk(x1[q][j][1][2], x1[q][j][1][3]);
          *(u32x4*)(Y + ro) = xw; }
#pragma unroll
        for (int h = 0; h < 2; ++h) ss[q] += (x1[q][j][h][0] * x1[q][j][h][0] + x1[q][j][h][1] * x1[q][j][h][1]) + (x1[q][j][h][2] * x1[q][j][h][2] + x1[q][j][h][3] * x1[q][j][h][3]);
      }
    }
    float r2[2];
#pragma unroll
    for (int q = 0; q < 2; ++q) r2[q] = rsqrtf(wave_sum(ss[q]) * (1.f / 2048.f) + EPS);
#pragma unroll
    for (int j = 0; j < 4; ++j) {
      const int c = j * 512 + lane * 8;
      const f32x4 ga = *(const f32x4*)(p.g_ffn_pre + c), gb = *(const f32x4*)(p.g_ffn_pre + c + 4);
#pragma unroll
      for (int q = 0; q < 2; ++q) {
        const f32x4 ha = x1[q][j][0] * r2[q] * ga, hb = x1[q][j][1] * r2[q] * gb;
        u32x4 w; w[0] = cvtpk(ha[0], ha[1]); w[1] = cvtpk(ha[2], ha[3]); w[2] = cvtpk(hb[0], hb[1]); w[3] = cvtpk(hb[2], hb[3]);
        *(u32x4*)(H + (size_t)(tb + q * 2048) * DM + c) = w;
      }
    }
  }
  xcd_barrier(xb);
  probe_end(5, pt5_, xb);
  const unsigned long long pt6_ = probe_begin(6);
  PH(6) { Epi<4> e; e.out = ACT; e.ldo = DFF; e.st_in = nullptr; e.st_out = nullptr;
    gemm_phase<4>(shm, rowsc, H, DM, WUP, 2048, 44, e, halo, HB, p.conv_w, p.conv_b);
    if (bid >= 128) {
      const int tid = opaque_tid(); float* tile = (float*)shm; f32x4 v[8]; TrTile tt;
      int ti = 2256 + (bid - 128);
      if (ti < 2960) { tt = tr_decode(p, ws, ti); tr_load(tt, v, tid); }
      for (; ti < 2960; ti += 128) {
        tr_to_lds(tt, v, tile, tid);
        __syncthreads();
        const TrTile cur = tt;
        if (ti + 128 < 2960) { tt = tr_decode(p, ws, ti + 128); tr_load(tt, v, tid); }
        tr_store(cur, tile, tid);
        __syncthreads();
      }
    } }
  xcd_barrier(xb);
  probe_end(6, pt6_, xb);
  const unsigned long long pt7_ = probe_begin(7);
  PH(7) for (int it = bid * 512 + opaque_tid(); it < 28 * 2 * 1408; it += nblk * 512) {
    const int c4 = it % 1408, rs = (it / 1408) & 1, pmi = it / 2816, pm = (pmi / 7) * 8 + (pmi % 7) + 1, ch = c4 * 4;
    const int colg = (ch >> 7) * 256 + (ch & 127), colv = colg + 128;
    const float* h0 = HB + (size_t)((pm - 1) * 4) * DFF2; const float* h1 = HB + (size_t)(pm * 4) * DFF2;
    const f32x4 gm2 = *(const f32x4*)(h0 + colg), gm1 = *(const f32x4*)(h0 + DFF2 + colg), g0 = *(const f32x4*)(h1 + 2 * DFF2 + colg), g1 = *(const f32x4*)(h1 + 3 * DFF2 + colg);
    const f32x4 vm2 = *(const f32x4*)(h0 + colv), vm1 = *(const f32x4*)(h0 + DFF2 + colv), v0 = *(const f32x4*)(h1 + 2 * DFF2 + colv), v1 = *(const f32x4*)(h1 + 3 * DFF2 + colv);
    const f32x4 cg = rs ? g1 : g0, pg1 = rs ? g0 : gm1, pg2 = rs ? gm1 : gm2, cv = rs ? v1 : v0, pv1 = rs ? v0 : vm1, pv2 = rs ? vm1 : vm2;
    const f32x4 wg0 = *(const f32x4*)(p.conv_w + ch), wg1 = *(const f32x4*)(p.conv_w + DFF2 + ch), wg2 = *(const f32x4*)(p.conv_w + 2 * DFF2 + ch), bg = *(const f32x4*)(p.conv_b + ch);
    const f32x4 wv0 = *(const f32x4*)(p.conv_w + DFF + ch), wv1 = *(const f32x4*)(p.conv_w + DFF2 + DFF + ch), wv2 = *(const f32x4*)(p.conv_w + 2 * DFF2 + DFF + ch), bv = *(const f32x4*)(p.conv_b + DFF + ch);
    const f32x4 ug = wg2 * cg + wg1 * pg1 + wg0 * pg2 + bg, uv = wv2 * cv + wv1 * pv1 + wv0 * pv2 + bv;
    u32x2 w; w[0] = cvtpk(gelu_tanh(ug[0]) * uv[0], gelu_tanh(ug[1]) * uv[1]); w[1] = cvtpk(gelu_tanh(ug[2]) * uv[2], gelu_tanh(ug[3]) * uv[3]);
    *(u32x2*)(ACT + (size_t)(pm * 256 + rs) * DFF + ch) = w;
  }
  xcd_barrier(xb);
  probe_end(7, pt7_, xb);
  const unsigned long long pt8_ = probe_begin(8);
  PH(8) { Epi<5> e; e.out = Y2; e.ldo = 2048; e.st_in = nullptr; e.st_out = STY2;
    gemm_phase<5>(shm, rowsc, ACT, DFF, WDN, DFF, 8, e); }
  xcd_barrier(xb);
  probe_end(8, pt8_, xb);
  const unsigned long long pt9_ = probe_begin(9);
  PH(9) {
    const int tid = opaque_tid(), wid = tid >> 6, lane = tid & 63;
    const int tb = bid * 8 + wid;
    float r[4];
#pragma unroll
    for (int q = 0; q < 4; ++q) {
      float s = STY2[(size_t)(tb + q * 2048) * 32 + (lane & 31)];
      s += __shfl_xor(s, 16); s += __shfl_xor(s, 8); s += __shfl_xor(s, 4); s += __shfl_xor(s, 2); s += __shfl_xor(s, 1);
      r[q] = rsqrtf(s * (1.f / 2048.f) + EPS);
    }
#pragma unroll
    for (int j = 0; j < 4; ++j) {
      const int c = j * 512 + lane * 8;
      const f32x4 ga = *(const f32x4*)(p.g_ffn_post + c), gb = *(const f32x4*)(p.g_ffn_post + c + 4);
#pragma unroll
      for (int q = 0; q < 4; ++q) {
        const size_t ro = (size_t)(tb + q * 2048) * DM + c;
        const u32x4 yw = *(const u32x4*)(Y2 + ro);
        const u32x4 xw = *(const u32x4*)(Y + ro);
        const f32x4 xa = {bf_lo(xw[0]), bf_hi(xw[0]), bf_lo(xw[1]), bf_hi(xw[1])}, xb2 = {bf_lo(xw[2]), bf_hi(xw[2]), bf_lo(xw[3]), bf_hi(xw[3])};
        const f32x4 ya = {bf_lo(yw[0]), bf_hi(yw[0]), bf_lo(yw[1]), bf_hi(yw[1])}, yb = {bf_lo(yw[2]), bf_hi(yw[2]), bf_lo(yw[3]), bf_hi(yw[3])};
        __builtin_nontemporal_store(xa + ya * r[q] * ga, (f32x4*)(p.out + ro)); __builtin_nontemporal_store(xb2 + yb * r[q] * gb, (f32x4*)(p.out + ro + 4));
      }
    }
  }
}

extern "C" void kernel_launch(void* const* d_in, const int* in_sizes, int n_in, void* d_out, int out_size, void* d_ws, size_t ws_size, hipStream_t stream) {
  if (n_in != 18 || ws_size < WS_END) { fprintf(stderr, "kernel_launch: unexpected n_in %d / ws_size %zu (need %zu)\n", n_in, ws_size, (size_t)WS_END); return; }
  static int grid_blocks = 0;
  if (!grid_blocks) {
    int dev = 0, cus = 0, per_cu = 0;
    (void)hipGetDevice(&dev);
    (void)hipDeviceGetAttribute(&cus, hipDeviceAttributeMultiprocessorCount, dev);
    (void)hipOccupancyMaxActiveBlocksPerMultiprocessor(&per_cu, fwd_kernel, 512, 0);
    if (per_cu < 1) per_cu = 1;
    grid_blocks = 256;
  }
  Params p{};
  p.x = (const float*)d_in[0]; p.pos = (const int*)d_in[1]; p.g_attn_pre = (const float*)d_in[2]; p.w_in = (const float*)d_in[3]; p.g_cq = (const float*)d_in[4];
  p.w_uq = (const float*)d_in[5]; p.g_ckv = (const float*)d_in[6]; p.w_ukv = (const float*)d_in[7]; p.g_out_sb = (const float*)d_in[8]; p.g_out_mla = (const float*)d_in[9];
  p.w_o = (const float*)d_in[10]; p.g_attn_post = (const float*)d_in[11]; p.g_ffn_pre = (const float*)d_in[12]; p.w_up = (const float*)d_in[13]; p.conv_w = (const float*)d_in[14];
  p.conv_b = (const float*)d_in[15]; p.w_down = (const float*)d_in[16]; p.g_ffn_post = (const float*)d_in[17]; p.out = (float*)d_out; p.ws = (char*)d_ws;
  (void)hipMemsetAsync((char*)d_ws + OFF_CNT, 0, 16384, stream);
  void* args[] = {&p};
  hipError_t e = hipLaunchCooperativeKernel((void*)fwd_kernel, dim3(grid_blocks), dim3(512), args, 0, stream);
  if (e != hipSuccess) fprintf(stderr, "cooperative launch failed: %s (grid %d)\n", hipGetErrorString(e), grid_blocks);
}
```

```cpp
#include <hip/hip_runtime.h>
#include <hip/hip_bf16.h>
#include <hip/hip_cooperative_groups.h>
#include <cstdio>
#include <cstdint>
namespace cg = cooperative_groups;

typedef unsigned short bf16_t;
using bf16x8 = __attribute__((ext_vector_type(8))) short;
using s16x4  = __attribute__((ext_vector_type(4))) short;
using f32x4  = __attribute__((ext_vector_type(4))) float;
using f32x16 = __attribute__((ext_vector_type(16))) float;
using u32x4  = __attribute__((ext_vector_type(4))) unsigned;
using u32x2  = __attribute__((ext_vector_type(2))) unsigned;
using i32x4  = __attribute__((ext_vector_type(4))) int;
#define DEV __device__ __forceinline__
#define LDS_AS __attribute__((address_space(3)))
#define GLB_AS __attribute__((address_space(1)))
#define SBAR() __builtin_amdgcn_sched_barrier(0)

constexpr int T_ = 8192, DM = 2048, SEQ = 2048;
constexpr int INC = 3904, INP = 4096, DFF = 5632, DFF2 = 11264;
constexpr float EPS = 1e-6f;
#ifndef PHASES
#define PHASES 0x3ff
#endif
#ifndef REPMASK
#define REPMASK 0
#endif
#define EXTRA_SYNC 0
#define AMP_PHASE -1
#define PH(k) if constexpr ((PHASES >> (k)) & 1) for (int rep_ = 0; rep_ < 1 + ((REPMASK >> (k)) & 1); ++rep_)
constexpr size_t MiB = 1024 * 1024;
constexpr size_t OFF_WIN = 0, OFF_WUQ = 16 * MiB, OFF_WUKV = OFF_WUQ + 3 * MiB / 2, OFF_WO = OFF_WUKV + MiB, OFF_H = OFF_WO + 8 * MiB,
                 OFF_Y = OFF_H + 32 * MiB, OFF_WUP = OFF_Y + 32 * MiB, OFF_WDN = OFF_WUP + 44 * MiB, OFF_UP = OFF_WDN + 22 * MiB,
                 OFF_PROJ = OFF_UP, OFF_Q = OFF_UP + 64 * MiB, OFF_KV = OFF_Q + 24 * MiB, OFF_O = OFF_KV + 32 * MiB, OFF_ACT = OFF_UP, OFF_Y2 = OFF_UP + 88 * MiB, OFF_HB = OFF_UP + 120 * MiB,
                 OFF_COS = OFF_UP + 176 * MiB, OFF_SIN = OFF_COS + MiB, OFF_STC = OFF_SIN + MiB, OFF_STO = OFF_STC + MiB / 2,
                 OFF_STY = OFF_STO + MiB / 2, OFF_STY2 = OFF_STY + MiB, OFF_KR = OFF_STY2 + MiB, OFF_CNT = OFF_KR + MiB, WS_END = OFF_CNT + 16384;

struct Params {
  const float* x; const int* pos; const float* g_attn_pre; const float* w_in; const float* g_cq; const float* w_uq; const float* g_ckv; const float* w_ukv;
  const float* g_out_sb; const float* g_out_mla; const float* w_o; const float* g_attn_post; const float* g_ffn_pre; const float* w_up; const float* conv_w;
  const float* conv_b; const float* w_down; const float* g_ffn_post; float* out; char* ws;
};

DEV unsigned cvtpk(float lo, float hi) { unsigned r; asm volatile("v_cvt_pk_bf16_f32 %0, %1, %2" : "=v"(r) : "v"(lo), "v"(hi)); return r; }
DEV float bf_lo(unsigned w) { return __uint_as_float(w << 16); }
DEV float bf_hi(unsigned w) { return __uint_as_float(w & 0xffff0000u); }
DEV int crow(int r, int hi) { return (r & 3) + 8 * (r >> 2) + 4 * hi; }
DEV int opaque_tid() { int t = threadIdx.x; asm volatile("" : "+v"(t)); return t; }
DEV float wave_sum(float s) {
  s += __shfl_xor(s, 32); s += __shfl_xor(s, 16); s += __shfl_xor(s, 8); s += __shfl_xor(s, 4); s += __shfl_xor(s, 2); s += __shfl_xor(s, 1); return s;
}

DEV const char* uptr(const void* p) {
  const unsigned long long v = (unsigned long long)p;
  const unsigned lo = __builtin_amdgcn_readfirstlane((unsigned)v), hi = __builtin_amdgcn_readfirstlane((unsigned)(v >> 32));
  return (const char*)(((unsigned long long)hi << 32) | lo);
}

#define XB_TMO      128
#define XB_XCNT(j)  (256  + 64 * (j))
#define XB_XSUB(j)  (1280 + 64 * (j))
#define XB_XGEN(j)  (2304 + 64 * (j))
#define XB_TOP      3328
#define XB_TOPGEN   3392
#define XB_QCNT     3456
#define XCD_BAR_WORDS 3520
#define XB_SPIN_CAP (1u << 18)
DEV unsigned xb_ld(unsigned* p)              { return __hip_atomic_load(p, __ATOMIC_RELAXED, __HIP_MEMORY_SCOPE_AGENT); }
DEV unsigned xb_add(unsigned* p, unsigned v) { return __hip_atomic_fetch_add(p, v, __ATOMIC_RELAXED, __HIP_MEMORY_SCOPE_AGENT); }
DEV unsigned xb_xcc_id() { return (unsigned)__builtin_amdgcn_s_getreg((3 << 11) | 20) & 0xFu; }
#define XB_SPIN(cond, bar) do { unsigned _sp = 0; while (cond) { __builtin_amdgcn_s_sleep(1); \
    if ((++_sp & 255u) == 0u) { if (xb_ld(&(bar)[XB_TMO])) break; if (_sp > XB_SPIN_CAP) { atomicAdd(&(bar)[XB_TMO], 1u); break; } } } } while (0)
struct XcdBarrier { unsigned* bar; unsigned x; volatile LDS_AS unsigned* st; };
DEV XcdBarrier xcd_barrier_post(unsigned* bar, volatile LDS_AS unsigned* st) {
  XcdBarrier b; b.bar = bar; b.x = xb_xcc_id(); b.st = st;
  if (threadIdx.x == 0) (void)xb_add(&bar[XB_XCNT(b.x)], 1u);
  return b;
}
DEV void xcd_barrier_complete(unsigned* bar, unsigned x, unsigned& nloc, unsigned& nx) {
  const unsigned G = gridDim.x * gridDim.y * gridDim.z;
  unsigned sum, cnt, mine, sp = 0u;
  for (;;) {
    sum = 0u; cnt = 0u; mine = 0u;
#pragma unroll
    for (unsigned j = 0; j < 16; ++j) { const unsigned c = xb_ld(&bar[XB_XCNT(j)]); sum += c; cnt += (c > 0u) ? 1u : 0u; mine = (j == x) ? c : mine; }
    if (sum == G) break;
    __builtin_amdgcn_s_sleep(1);
    if ((++sp & 255u) == 0u) { if (xb_ld(&bar[XB_TMO])) break; if (sp > XB_SPIN_CAP) { atomicAdd(&bar[XB_TMO], 1u); break; } }
  }
  nloc = mine > 0u ? mine : 1u; nx = cnt > 0u ? cnt : 1u;
}
DEV void xcd_barrier(const XcdBarrier& b) {
  asm volatile("s_waitcnt vmcnt(0)" ::: "memory");
  __syncthreads();
  if (threadIdx.x == 0) {
    unsigned* bar = b.bar;
    __builtin_amdgcn_s_waitcnt(0);
    unsigned nloc = b.st[0], nx = b.st[1];
    if (nloc == 0u) { xcd_barrier_complete(bar, b.x, nloc, nx); b.st[0] = nloc; b.st[1] = nx; }
    const unsigned old = xb_add(&bar[XB_XSUB(b.x)], 1u);
    const unsigned gen = old / nloc;
    if (old + 1u == (gen + 1u) * nloc) {
      __builtin_amdgcn_fence(__ATOMIC_RELEASE, "agent");
      asm volatile("s_waitcnt vmcnt(0)" ::: "memory");
      const unsigned og = xb_add(&bar[XB_TOP], 1u);
      const unsigned tg = og / nx;
      if (og + 1u == (tg + 1u) * nx) xb_add(&bar[XB_TOPGEN], 1u);
      else XB_SPIN(xb_ld(&bar[XB_TOPGEN]) == tg, bar);
      __builtin_amdgcn_fence(__ATOMIC_ACQUIRE, "agent");
      xb_add(&bar[XB_XGEN(b.x)], 1u);
      asm volatile("s_waitcnt vmcnt(0)" ::: "memory");
    } else {
      XB_SPIN(xb_ld(&bar[XB_XGEN(b.x)]) == gen, bar);
      __builtin_amdgcn_fence(__ATOMIC_ACQUIRE, "agent");
      asm volatile("s_waitcnt vmcnt(0)" ::: "memory");
    }
  }
  __syncthreads();
}
DEV int lds_byte2(int r, int c) { int st = (r >> 4) * 2 + (c >> 5), ob = (r & 15) * 64 + (c & 31) * 2; return st * 1024 + (ob ^ (((ob >> 9) & 1) << 5)); }
DEV void stage_rc2(int b, int& R, int& C) { int st = b >> 10, sb = b & 1023, swz = sb ^ (((sb >> 9) & 1) << 5); R = (st >> 1) * 16 + swz / 64; C = (st & 1) * 32 + (swz % 64) / 2; }

DEV float gelu_tanh(float x) {
  const float u = x + 0.044715f * x * x * x;
  return x * __builtin_amdgcn_rcpf(1.f + __builtin_amdgcn_exp2f(-2.302208198f * u));
}

DEV float dpp_shr1(float old, float src) {
  return __int_as_float(__builtin_amdgcn_update_dpp(__float_as_int(old), __float_as_int(src), 0x111, 0xf, 0xf, false));
}
DEV void epi_up(const f32x4 (&acc)[2][2][4][2], int pm, int pn, int wr, int wc, int fr, int fq, float* halo, bf16_t* ACTp, float* HB, const float* conv_w, const float* conv_b) {
  if (fr == 15) {
#pragma unroll
    for (int ai = 0; ai < 2; ++ai)
#pragma unroll
      for (int rs = 0; rs < 2; ++rs)
#pragma unroll
        for (int bj = 0; bj < 2; ++bj)
#pragma unroll
          for (int n = 0; n < 2; ++n) *(f32x4*)(halo + (((ai * 2 + wr) * 4 + wc) * 2 + rs) * 64 + (bj * 2 + n) * 16 + fq * 4) = acc[ai][bj][2 + rs][n];
  }
  {
    GLB_AS char* hb = (GLB_AS char*)uptr(HB);
    if (wr == 1 && fr == 15) {
#pragma unroll
      for (int rs = 0; rs < 2; ++rs)
#pragma unroll
        for (int bj = 0; bj < 2; ++bj)
#pragma unroll
          for (int n = 0; n < 2; ++n) *(GLB_AS f32x4*)(hb + (unsigned)((pm * 4 + rs) * DFF2 + pn * 256 + bj * 128 + wc * 32 + 8 * fq + 4 * n) * 4u) = acc[1][bj][2 + rs][n];
    }
    if (wr == 0 && fr == 0) {
#pragma unroll
      for (int rs = 0; rs < 2; ++rs)
#pragma unroll
        for (int bj = 0; bj < 2; ++bj)
#pragma unroll
          for (int n = 0; n < 2; ++n) *(GLB_AS f32x4*)(hb + (unsigned)((pm * 4 + 2 + rs) * DFF2 + pn * 256 + bj * 128 + wc * 32 + 8 * fq + 4 * n) * 4u) = acc[0][bj][rs][n];
    }
  }
  asm volatile("s_waitcnt lgkmcnt(0)" ::: "memory"); __builtin_amdgcn_s_barrier(); asm volatile("" ::: "memory");
  GLB_AS char* ap = (GLB_AS char*)uptr(ACTp);
#pragma unroll
  for (int n = 0; n < 2; ++n) {
    const int chb = pn * 128 + wc * 32 + 8 * fq + 4 * n;
    const f32x4 wg0 = *(const f32x4*)(conv_w + chb), wg1 = *(const f32x4*)(conv_w + DFF2 + chb), wg2 = *(const f32x4*)(conv_w + 2 * DFF2 + chb), bg = *(const f32x4*)(conv_b + chb);
    const f32x4 wv0 = *(const f32x4*)(conv_w + DFF + chb), wv1 = *(const f32x4*)(conv_w + DFF2 + DFF + chb), wv2 = *(const f32x4*)(conv_w + 2 * DFF2 + DFF + chb), bv = *(const f32x4*)(conv_b + DFF + chb);
#pragma unroll
    for (int ai = 0; ai < 2; ++ai) {
      f32x4 hg2 = {0.f, 0.f, 0.f, 0.f}, hg3 = hg2, hv2 = hg2, hv3 = hg2;
      if ((wr == 1 || ai == 1) && fr == 0) {
        const int sai = wr == 1 ? ai : 0, swr = wr == 1 ? 0 : 1;
        const float* hp = halo + ((sai * 2 + swr) * 4 + wc) * 128 + fq * 4;
        hg2 = *(const f32x4*)(hp + n * 16); hv2 = *(const f32x4*)(hp + (2 + n) * 16); hg3 = *(const f32x4*)(hp + 64 + n * 16); hv3 = *(const f32x4*)(hp + 64 + (2 + n) * 16);
      }
      f32x4 sg2, sg3, sv2, sv3;
#pragma unroll
      for (int j = 0; j < 4; ++j) {
        sg2[j] = dpp_shr1(hg2[j], acc[ai][0][2][n][j]); sg3[j] = dpp_shr1(hg3[j], acc[ai][0][3][n][j]);
        sv2[j] = dpp_shr1(hv2[j], acc[ai][1][2][n][j]); sv3[j] = dpp_shr1(hv3[j], acc[ai][1][3][n][j]);
      }
#pragma unroll
      for (int m = 0; m < 4; ++m) {
        const f32x4 cg = acc[ai][0][m][n], cv = acc[ai][1][m][n];
        const f32x4 g1 = m == 0 ? sg3 : acc[ai][0][m == 0 ? 0 : m - 1][n], g2 = m == 0 ? sg2 : (m == 1 ? sg3 : acc[ai][0][m < 2 ? 0 : m - 2][n]);
        const f32x4 v1 = m == 0 ? sv3 : acc[ai][1][m == 0 ? 0 : m - 1][n], v2 = m == 0 ? sv2 : (m == 1 ? sv3 : acc[ai][1][m < 2 ? 0 : m - 2][n]);
        const f32x4 ug = wg2 * cg + wg1 * g1 + wg0 * g2 + bg, uv = wv2 * cv + wv1 * v1 + wv0 * v2 + bv;
        const int row = pm * 256 + ai * 128 + wr * 64 + 4 * fr + m;
        u32x2 w; w[0] = cvtpk(gelu_tanh(ug[0]) * uv[0], gelu_tanh(ug[1]) * uv[1]); w[1] = cvtpk(gelu_tanh(ug[2]) * uv[2], gelu_tanh(ug[3]) * uv[3]);
        *(GLB_AS u32x2*)(ap + (unsigned)(row * DFF + chb) * 2u) = w;
      }
      asm volatile("" ::: "memory");
    }
  }
}

DEV int perm32(int rho) { const int n = rho >> 4, i = rho & 15; return 8 * (i >> 2) + 4 * n + (i & 3); }
struct Unit { int pm, pn; };
struct Sched {
  int nN, nUnits, G, c;
  DEV bool next(int i, Unit& u) const { const int L = i * G + c; if (L >= nUnits) return false; u.pm = (L & 15) + 16 * (L / (16 * nN)); u.pn = (L >> 4) % nN; return true; }
};
template <int MODE> struct Epi {
  bf16_t* out; int ldo; const float* st_in; float* st_out; bf16_t* outK; bf16_t* outV;
  DEV void prep(float* rsc, int row0, int tid) const {
    if (tid < 256) {
      const float* sp = st_in + (size_t)(row0 + tid) * 16;
      const f32x4 a0 = *(const f32x4*)(sp), a1 = *(const f32x4*)(sp + 4), b0 = *(const f32x4*)(sp + 8), b1 = *(const f32x4*)(sp + 12);
      const float ssb = (a0[0] + a0[1]) + (a0[2] + a0[3]) + (a1[0] + a1[1]) + (a1[2] + a1[3]);
      const float sml = (b0[0] + b0[1]) + (b0[2] + b0[3]) + (b1[0] + b1[1]) + (b1[2] + b1[3]);
      const float rsb = rsqrtf(ssb * (1.f / 1024.f) + EPS), rml = rsqrtf(sml * (1.f / 1024.f) + EPS);
      rsc[tid] = rsb / rml; rsc[256 + tid] = rml;
    }
  }
  DEV void hook(f32x4 (&acc)[2][2][4][2], const float* rsc, int wr, int fr) const {
#pragma unroll
    for (int ai = 0; ai < 2; ++ai)
#pragma unroll
      for (int m = 0; m < 4; ++m) {
        const float ratio = rsc[ai * 128 + wr * 64 + m * 16 + fr];
#pragma unroll
        for (int bj = 0; bj < 2; ++bj)
#pragma unroll
          for (int n = 0; n < 2; ++n) acc[ai][bj][m][n] *= ratio;
      }
  }
  DEV void operator()(const f32x4 (&acc)[2][2][4][2], int pm, int pn, int wr, int wc, int fr, int fq, const float* rsc) const {
    const bool do_stat = MODE == 0 ? (pn >= 12 && pn < 15) : (MODE == 3 || MODE == 5);
    const int slot = MODE == 0 ? ((pn - 12) * 4 + wc) : (pn * 4 + wc);
    constexpr int SS = MODE == 0 ? 16 : 32;
    GLB_AS char* ob = (GLB_AS char*)uptr(out);
#pragma unroll
    for (int ai = 0; ai < 2; ++ai)
#pragma unroll
      for (int m = 0; m < 4; ++m) {
        const int rloc = ai * 128 + wr * 64 + m * 16 + fr, row = pm * 256 + rloc;
        float rs = (MODE == 0 && pn < 4) ? 0.08838834764831845f * 1.4426950408889634f : 1.f;
        if (MODE == 1) { const float* sp = st_in + (size_t)row * 16; const f32x4 a0 = *(const f32x4*)(sp), a1 = *(const f32x4*)(sp + 4);
          rs = rsqrtf(((a0[0] + a0[1]) + (a0[2] + a0[3]) + (a1[0] + a1[1]) + (a1[2] + a1[3])) * (1.f / 512.f) + EPS); }
        if (MODE == 2) { const f32x4 a0 = *(const f32x4*)(st_in + (size_t)row * 16 + 8); rs = rsqrtf(((a0[0] + a0[1]) + (a0[2] + a0[3])) * (1.f / 256.f) + EPS); }
        if (MODE == 3) rs = rsc[256 + rloc];
        f32x4 v[2][2];
#pragma unroll
        for (int bj = 0; bj < 2; ++bj)
#pragma unroll
          for (int n = 0; n < 2; ++n) v[bj][n] = acc[ai][bj][m][n] * rs;
        if (MODE == 0 || MODE == 3 || MODE == 5) {
          if (do_stat) {
            float s = 0.f;
#pragma unroll
            for (int bj = 0; bj < 2; ++bj)
#pragma unroll
              for (int n = 0; n < 2; ++n) s += (v[bj][n][0] * v[bj][n][0] + v[bj][n][1] * v[bj][n][1]) + (v[bj][n][2] * v[bj][n][2] + v[bj][n][3] * v[bj][n][3]);
            s += __shfl_xor(s, 16); s += __shfl_xor(s, 32);
            *(GLB_AS float*)((GLB_AS char*)uptr(st_out) + (unsigned)(row * SS + slot) * 4u) = s;
          }
        }
        u32x4 w[2];
#pragma unroll
        for (int bj = 0; bj < 2; ++bj) { w[bj][0] = cvtpk(v[bj][0][0], v[bj][0][1]); w[bj][1] = cvtpk(v[bj][0][2], v[bj][0][3]); w[bj][2] = cvtpk(v[bj][1][0], v[bj][1][1]); w[bj][3] = cvtpk(v[bj][1][2], v[bj][1][3]); }
        if (MODE == 0 && pn >= 4 && pn < 12) {
          GLB_AS char* hb_ = (GLB_AS char*)uptr(pn < 8 ? outK : outV);
#pragma unroll
          for (int bj = 0; bj < 2; ++bj) { const int hh = (pn & 3) * 2 + bj;
            *(GLB_AS u32x4*)(hb_ + (unsigned)((((row >> 11) * 8 + hh) * 2048 + (row & 2047)) * 128 + wc * 32 + 8 * fq) * 2u) = w[bj]; }
        } else if (MODE == 2) {
          const unsigned ho = (unsigned)((((row >> 11) * 8 + pn) * 2048 + (row & 2047)) * 128 + wc * 32 + 8 * fq) * 2u;
          *(GLB_AS u32x4*)((GLB_AS char*)uptr(outK) + ho) = w[0]; *(GLB_AS u32x4*)((GLB_AS char*)uptr(outV) + ho) = w[1];
        } else {
          const unsigned oo = (unsigned)(row * ldo + pn * 256 + wc * 32 + 8 * fq) * 2u;
          *(GLB_AS u32x4*)(ob + oo) = w[0]; *(GLB_AS u32x4*)(ob + oo + 256) = w[1];
        }
        asm volatile("" ::: "memory");
      }
  }
};

template <int MODE>
DEV void gemm_phase(char* shm, float* rowsc, const bf16_t* __restrict__ A, int lda, const bf16_t* __restrict__ Bt, int K, int nN, const Epi<MODE>& E,
                    float* halo = nullptr, float* HBp = nullptr, const float* conv_w = nullptr, const float* conv_b = nullptr) {
  constexpr int HALF = 128, HTB = HALF * 64 * 2;
  LDS_AS unsigned char* lds = (LDS_AS unsigned char*)shm;
  const int tid = opaque_tid(), wid = __builtin_amdgcn_readfirstlane(tid >> 6), lane = tid & 63, wr = wid >> 2, wc = wid & 3, fr = lane & 15, fq = lane >> 4;
  const int nt = K / 64;
  Sched S; S.nN = nN; S.nUnits = 32 * nN; S.G = gridDim.x; S.c = blockIdx.x;
  unsigned voffA[2], voffB[2];
#pragma unroll
  for (int i = 0; i < 2; ++i) { int R, C; stage_rc2(tid * 16 + i * 8192, R, C); const int Rb = (R & ~31) + perm32(R & 31);
    const int Ra = MODE == 4 ? ((R & 64) | ((R & 15) << 2) | ((R >> 4) & 3)) : R;
    voffA[i] = (unsigned)(Ra * lda + C) * 2u; voffB[i] = (unsigned)(Rb * K + C) * 2u; }
  const size_t kstep = 128;
  const size_t hstepA = (size_t)HALF * lda * 2, hstepB = (size_t)HALF * K * 2, tstepA = 2 * hstepA, tstepB = 2 * hstepB;
  const unsigned ldsw = (unsigned)wid * 1024u;
  const int aoff = lds_byte2(wr * 64 + fr, fq * 8), boff = lds_byte2(wc * 32 + fr, fq * 8);
  LDS_AS unsigned char* pa = lds + aoff; LDS_AS unsigned char* pb = lds + 4 * HTB + boff;
  asm volatile("" : "+v"(pa), "+v"(pb));
#define PG8_SA(b, h) (((b) * 2 + (h)) * HTB)
#define PG8_SB(b, h) ((4 + (b) * 2 + (h)) * HTB)
#define PG8_STAGE(bufoff, gbase, voff) do { const char* gb_ = uptr(gbase); _Pragma("unroll") for (int _i = 0; _i < 2; ++_i) \
        __builtin_amdgcn_global_load_lds((const unsigned*)(gb_ + (voff)[_i]), (LDS_AS unsigned*)(lds + (bufoff) + ldsw + _i * 8192), 16, 0, 0); } while (0)
#define PG8_LDA(dst, b, h) do { _Pragma("unroll") for (int m = 0; m < 4; ++m) _Pragma("unroll") for (int k = 0; k < 2; ++k) dst[m][k] = *(const LDS_AS bf16x8*)(pa + (PG8_SA(b, h) + m * 2048 + k * 1024)); } while (0)
#define PG8_LDB(dst, b, h) do { _Pragma("unroll") for (int n = 0; n < 2; ++n) _Pragma("unroll") for (int k = 0; k < 2; ++k) dst[n][k] = *(const LDS_AS bf16x8*)(pb + (PG8_SA(b, h) + n * 2048 + k * 1024)); } while (0)
#define PG8_MMA(ai, bj, At, Bt_) do { __builtin_amdgcn_s_setprio(1); _Pragma("unroll") for (int m = 0; m < 4; ++m) _Pragma("unroll") for (int n = 0; n < 2; ++n) _Pragma("unroll") for (int k = 0; k < 2; ++k) \
        acc[ai][bj][m][n] = __builtin_amdgcn_mfma_f32_16x16x32_bf16(Bt_[n][k], At[m][k], acc[ai][bj][m][n], 0, 0, 0); __builtin_amdgcn_s_setprio(0); } while (0)
#define PG8_WAIT_V(n) asm volatile("s_waitcnt vmcnt(" #n ")" ::: "memory")
#define PG8_WAIT_L(n) asm volatile("s_waitcnt lgkmcnt(" #n ")" ::: "memory")
#define PG8_BAR __builtin_amdgcn_s_barrier()
#define PG8_SCHED __builtin_amdgcn_sched_barrier(0)
  Unit cur, nxt; int ui = 0;
  if (!S.next(0, cur)) return;
  f32x4 acc[2][2][4][2];
#pragma unroll
  for (int a = 0; a < 2; ++a)
#pragma unroll
    for (int b = 0; b < 2; ++b)
#pragma unroll
      for (int m = 0; m < 4; ++m)
#pragma unroll
        for (int n = 0; n < 2; ++n) acc[a][b][m][n] = (f32x4){0.f, 0.f, 0.f, 0.f};
  bf16x8 At[4][2], B0[2][2], B1[2][2];
  const char* cA = (const char*)A + (size_t)cur.pm * tstepA; const char* cB = (const char*)Bt + (size_t)cur.pn * tstepB;
  if (MODE == 3) E.prep(rowsc, cur.pm * 256, tid);
  PG8_STAGE(PG8_SB(0, 0), cB, voffB); PG8_STAGE(PG8_SB(0, 1), cB + hstepB, voffB); PG8_STAGE(PG8_SA(0, 0), cA, voffA); PG8_STAGE(PG8_SA(0, 1), cA + hstepA, voffA);
  if (wr == 1) PG8_BAR;
  PG8_WAIT_V(2); PG8_BAR;
  PG8_STAGE(PG8_SB(1, 0), cB + kstep, voffB); PG8_STAGE(PG8_SA(1, 0), cA + kstep, voffA); PG8_STAGE(PG8_SB(1, 1), cB + hstepB + kstep, voffB);
  PG8_WAIT_V(6); PG8_BAR;
  for (;;) {
    const bool has_next = S.next(ui + 1, nxt);
    const char* nA = has_next ? (const char*)A + (size_t)nxt.pm * tstepA : cA; const char* nB = has_next ? (const char*)Bt + (size_t)nxt.pn * tstepB : cB;
    const float* rsc = rowsc + (ui & 1) * 512;
    for (int t = 0; t < nt; t += 2) {
      const bool last = (t == nt - 2);
      const char* a1 = cA + (size_t)(t + 1) * kstep;
      const char* a2 = last ? nA : cA + (size_t)(t + 2) * kstep; const char* b2 = last ? nB : cB + (size_t)(t + 2) * kstep;
      const char* a3 = a2 + kstep; const char* b3 = b2 + kstep;
      if (MODE == 3) { if (t == 16) E.hook(acc, rsc, wr, fr); }
      PG8_LDB(B0, 0, 0); PG8_LDB(B1, 0, 1); PG8_SCHED; PG8_LDA(At, 0, 0); PG8_STAGE(PG8_SA(1, 1), a1 + hstepA, voffA);
      PG8_WAIT_V(8); PG8_WAIT_L(0); PG8_BAR; PG8_MMA(0, 0, At, B0); PG8_MMA(0, 1, At, B1); PG8_BAR; PG8_SCHED;
      PG8_LDA(At, 0, 1); PG8_STAGE(PG8_SB(0, 0), b2, voffB); PG8_STAGE(PG8_SB(0, 1), b2 + hstepB, voffB); PG8_STAGE(PG8_SA(0, 0), a2, voffA);
      PG8_WAIT_V(8); PG8_WAIT_L(0); PG8_BAR; PG8_MMA(1, 0, At, B0); PG8_MMA(1, 1, At, B1); PG8_BAR; PG8_SCHED;
      PG8_LDB(B0, 1, 0); PG8_LDB(B1, 1, 1); PG8_SCHED; PG8_LDA(At, 1, 0); PG8_STAGE(PG8_SA(0, 1), a2 + hstepA, voffA);
      PG8_WAIT_V(8); PG8_WAIT_L(0); PG8_BAR; PG8_MMA(0, 0, At, B0); PG8_MMA(0, 1, At, B1); PG8_BAR; PG8_SCHED;
      PG8_LDA(At, 1, 1); PG8_STAGE(PG8_SB(1, 0), b3, voffB); PG8_STAGE(PG8_SB(1, 1), b3 + hstepB, voffB); PG8_STAGE(PG8_SA(1, 0), a3, voffA);
      PG8_WAIT_V(8); PG8_WAIT_L(0); PG8_BAR; PG8_MMA(1, 0, At, B0); PG8_MMA(1, 1, At, B1); PG8_BAR; PG8_SCHED;
    }
    if (wr == 0) PG8_BAR;
    { const int t2 = opaque_tid();
      if (MODE == 4) epi_up(acc, cur.pm, cur.pn, (t2 >> 8) & 1, (t2 >> 6) & 3, t2 & 15, (t2 >> 4) & 3, halo, E.out, HBp, conv_w, conv_b);
      else E(acc, cur.pm, cur.pn, (t2 >> 8) & 1, (t2 >> 6) & 3, t2 & 15, (t2 >> 4) & 3, rsc); }
    if (!has_next) break;
#pragma unroll
    for (int a = 0; a < 2; ++a)
#pragma unroll
      for (int b = 0; b < 2; ++b)
#pragma unroll
        for (int m = 0; m < 4; ++m)
#pragma unroll
          for (int n = 0; n < 2; ++n) acc[a][b][m][n] = (f32x4){0.f, 0.f, 0.f, 0.f};
    cur = nxt; cA = nA; cB = nB; ++ui;
    if (MODE == 3) E.prep(rowsc + (ui & 1) * 512, cur.pm * 256, tid);
    if (wr == 1) PG8_BAR;
  }
  PG8_WAIT_V(0);
  PG8_BAR;
#undef PG8_SA
#undef PG8_SB
#undef PG8_STAGE
#undef PG8_LDA
#undef PG8_LDB
#undef PG8_MMA
#undef PG8_WAIT_V
#undef PG8_WAIT_L
#undef PG8_BAR
#undef PG8_SCHED
}

DEV int v_st(int k, int c) { const int kk = (k & ~0xC) | ((k & 4) << 1) | ((k & 8) >> 1); return ((kk >> 3) * 4 + (c >> 5)) * 512 + ((kk & 7) * 32 + (c & 31)) * 2; }
DEV int v_rd_base(int lane) { return ((lane & 3) << 3) | (((lane >> 2) & 3) << 6) | (((lane >> 4) & 1) << 5) | (((lane >> 5) & 1) << 8); }
constexpr int v_rd_off(int d0, int ks, int half) { return d0 * 512 + ks * 4096 + half * 2048; }
template <int OFF> DEV s16x4 tr_read(int vb) { s16x4 r; asm volatile("ds_read_b64_tr_b16 %0, %1 offset:%2" : "=&v"(r) : "v"(vb), "i"(OFF) : "memory"); return r; }
template <int D0> DEV void pv_one(f32x16& od, int vb, bf16x8 pa0, bf16x8 pa1, bf16x8 pa2, bf16x8 pa3) {
  const s16x4 l0 = tr_read<v_rd_off(D0, 0, 0)>(vb), h0 = tr_read<v_rd_off(D0, 0, 1)>(vb), l1 = tr_read<v_rd_off(D0, 1, 0)>(vb), h1 = tr_read<v_rd_off(D0, 1, 1)>(vb);
  const s16x4 l2 = tr_read<v_rd_off(D0, 2, 0)>(vb), h2 = tr_read<v_rd_off(D0, 2, 1)>(vb), l3 = tr_read<v_rd_off(D0, 3, 0)>(vb), h3 = tr_read<v_rd_off(D0, 3, 1)>(vb);
  asm volatile("s_waitcnt lgkmcnt(0)" ::: "memory"); SBAR();
#define PKV(L, H) (bf16x8){L[0], L[1], L[2], L[3], H[0], H[1], H[2], H[3]}
  od = __builtin_amdgcn_mfma_f32_32x32x16_bf16(pa0, PKV(l0, h0), od, 0, 0, 0);
  od = __builtin_amdgcn_mfma_f32_32x32x16_bf16(pa1, PKV(l1, h1), od, 0, 0, 0);
  od = __builtin_amdgcn_mfma_f32_32x32x16_bf16(pa2, PKV(l2, h2), od, 0, 0, 0);
  od = __builtin_amdgcn_mfma_f32_32x32x16_bf16(pa3, PKV(l3, h3), od, 0, 0, 0);
#undef PKV
}
#define PK4(P, BASE, OUT) do { unsigned a0_ = cvtpk(P[BASE + 0], P[BASE + 1]), a1_ = cvtpk(P[BASE + 2], P[BASE + 3]);   \
    unsigned b0_ = cvtpk(P[BASE + 4], P[BASE + 5]), b1_ = cvtpk(P[BASE + 6], P[BASE + 7]);                              \
    auto r0_ = __builtin_amdgcn_permlane32_swap(a0_, b0_, false, false); auto r1_ = __builtin_amdgcn_permlane32_swap(a1_, b1_, false, false); \
    u32x4 w_ = {r0_[0], r1_[0], r0_[1], r1_[1]}; OUT = *reinterpret_cast<bf16x8*>(&w_); } while (0)

DEV void sb_half(f32x16& P, float& run, bool diag, int key0, int qrow, int hi) {
  constexpr float C = 0.08838834764831845f * 1.4426950408889634f;
#pragma unroll
  for (int r = 0; r < 16; ++r) P[r] = fmaxf(P[r], -100.f);
  if (diag) {
#pragma unroll
    for (int r = 0; r < 16; ++r) { if (key0 + crow(r, hi) >= qrow) P[r] = -100.f; }
  }
  f32x16 L;
#pragma unroll
  for (int r = 0; r < 16; ++r) { const float em = __builtin_amdgcn_exp2f(-P[r]); const float be = __builtin_amdgcn_rcpf(1.f + em); P[r] = be; L[r] = em * be; }
#pragma unroll
  for (int g = 3; g >= 0; --g) {
    const float gs = (L[4 * g] * L[4 * g + 1]) * (L[4 * g + 2] * L[4 * g + 3]);
    auto rr = __builtin_amdgcn_permlane32_swap(__float_as_uint(gs), __float_as_uint(gs), false, false);
    const float lo = __uint_as_float(rr[0]), hv = __uint_as_float(rr[1]);
    const float e3 = run * (hi == 0 ? hv : 1.f), e2 = e3 * L[4 * g + 3], e1 = e2 * L[4 * g + 2], e0 = e1 * L[4 * g + 1];
    run *= lo * hv;
    P[4 * g + 3] *= e3; P[4 * g + 2] *= e2; P[4 * g + 1] *= e1; P[4 * g + 0] *= e0;
  }
}
DEV void sb_tile(f32x16& p0, f32x16& p1, float& carry, bool diag, int kt0, int qrow, int hi) {
  sb_half(p1, carry, diag, kt0 + 32, qrow, hi);
  sb_half(p0, carry, diag, kt0, qrow, hi);
}

template <bool MLA>
DEV void attn_unit(char* lds, const bf16_t* __restrict__ Qb, int ldq, const bf16_t* __restrict__ Kb, int ldk, const bf16_t* __restrict__ Krb, int ldkr,
                   const bf16_t* __restrict__ Vb, int ldv, bf16_t* __restrict__ Ob, int ldo, float* __restrict__ statb, int qb, const float* __restrict__ cosb, const float* __restrict__ sinb) {
  constexpr int DQ = MLA ? 192 : 128, ND = DQ / 16, ROWB = DQ * 2, SHMK = 64 * ROWB, SHMV = 16384, VOFF = 2 * SHMK, SCR = VOFF + 3 * SHMV;
#define KSWZ(row, colB) ((row) * ROWB + ((colB) ^ (((row) & 7) << 4)))
  const int tid = opaque_tid(), wid = tid >> 6, lane = tid & 63, r32 = lane & 31, hi = lane >> 5;
  float* al_l = (float*)(lds + SCR + wid * 256); float* li_l = al_l + 32;
  char* qlds = lds + SCR + 2048 + wid * 4096 + lane * 16;
  const int q0w = 256 * qb + 32 * wid, qrow = q0w + r32;
  bf16x8 qr[ND];
  { const bf16_t* Qw = Qb + (size_t)qrow * ldq + hi * 8;
#pragma unroll
    for (int d0 = 0; d0 < ND; ++d0) qr[d0] = *(const bf16x8*)(Qw + d0 * 16); }
  if (MLA) {
#pragma unroll
    for (int dd = 0; dd < 2; ++dd) {
      const float* cp = cosb + (size_t)qrow * 32 + dd * 16 + hi * 8; const float* sp = sinb + (size_t)qrow * 32 + dd * 16 + hi * 8;
      const f32x4 c0 = *(const f32x4*)cp, c1 = *(const f32x4*)(cp + 4), s0 = *(const f32x4*)sp, s1 = *(const f32x4*)(sp + 4);
      const u32x4 a = __builtin_bit_cast(u32x4, qr[ND - 4 + dd]), b = __builtin_bit_cast(u32x4, qr[ND - 2 + dd]);
      u32x4 ya, yb;
#pragma unroll
      for (int q = 0; q < 4; ++q) {
        const float cl = q < 2 ? c0[2 * q] : c1[2 * q - 4], ch = q < 2 ? c0[2 * q + 1] : c1[2 * q - 3];
        const float sl = q < 2 ? s0[2 * q] : s1[2 * q - 4], sh = q < 2 ? s0[2 * q + 1] : s1[2 * q - 3];
        const float x1l = bf_lo(a[q]), x1h = bf_hi(a[q]), x2l = bf_lo(b[q]), x2h = bf_hi(b[q]);
        ya[q] = cvtpk(x1l * cl - x2l * sl, x1h * ch - x2h * sh); yb[q] = cvtpk(x1l * sl + x2l * cl, x1h * sh + x2h * ch);
      }
      qr[ND - 4 + dd] = __builtin_bit_cast(bf16x8, ya); qr[ND - 2 + dd] = __builtin_bit_cast(bf16x8, yb);
    }
#pragma unroll
    for (int d = 0; d < 4; ++d) *(bf16x8*)(qlds + d * 1024) = qr[ND - 4 + d];
  }
  f32x16 o[4];
#pragma unroll
  for (int d = 0; d < 4; ++d)
#pragma unroll
    for (int r = 0; r < 16; ++r) o[d][r] = 0.f;
  float carry = 1.f, m_reg = -1e30f, l_reg = 0.f;
  const int NT = 4 * qb + 4, jmax = 4 * qb + (wid >> 1);
  const int sr = tid >> 4, sc = (tid & 15) * 8, vst0 = v_st(sr, sc), vst1 = v_st(32 + sr, sc), krr = tid >> 3, krc = (tid & 7) * 8;
  const int vb0 = (int)(unsigned)(uintptr_t)(lds + VOFF) + v_rd_base(lane);
  bf16x8 ks0, ks1, vs0, vs1, kx;
#define A_LOAD(jt) do { const int kt0_ = (jt) * 64; \
    ks0 = *(const bf16x8*)(Kb + (size_t)(kt0_ + sr) * ldk + sc); ks1 = *(const bf16x8*)(Kb + (size_t)(kt0_ + 32 + sr) * ldk + sc); \
    vs0 = *(const bf16x8*)(Vb + (size_t)(kt0_ + sr) * ldv + sc); vs1 = *(const bf16x8*)(Vb + (size_t)(kt0_ + 32 + sr) * ldv + sc); \
    if (MLA) kx = *(const bf16x8*)(Krb + (size_t)(kt0_ + krr) * ldkr + krc); SBAR(); } while (0)
#define A_WRITE(kb, vslot) do { char* base_ = lds + (kb) * SHMK; char* vbase_ = lds + VOFF + (vslot) * SHMV; \
    *(bf16x8*)(base_ + KSWZ(sr, sc * 2)) = ks0; *(bf16x8*)(base_ + KSWZ(32 + sr, sc * 2)) = ks1; \
    *(bf16x8*)(vbase_ + vst0) = vs0; *(bf16x8*)(vbase_ + vst1) = vs1; \
    if (MLA) *(bf16x8*)(base_ + KSWZ(krr, (128 + krc) * 2)) = kx; } while (0)
#define A_PV(vslot) do { const int vb_ = vb0 + (vslot) * SHMV; \
    pv_one<0>(o[0], vb_, pa0, pa1, pa2, pa3); pv_one<1>(o[1], vb_, pa0, pa1, pa2, pa3); pv_one<2>(o[2], vb_, pa0, pa1, pa2, pa3); pv_one<3>(o[3], vb_, pa0, pa1, pa2, pa3); } while (0)
  const bool late = wid >= 4; bool pend = false;
  if (late) __builtin_amdgcn_s_setprio(1);
  bool done_w = false; int* dflag = (int*)(lds + SCR + 2048);
  bf16x8 pa0, pa1, pa2, pa3;
  A_LOAD(NT - 1); A_WRITE(0, 0); A_LOAD(NT - 2); __syncthreads();
  int vs = 0;
  for (int i = 0; i < NT; ++i) {
    const int jt = NT - 1 - i, cur = i & 1, vnext = vs == 2 ? 0 : vs + 1, vprev = vs == 0 ? 2 : vs - 1;
    if (i + 1 < NT) A_WRITE(cur ^ 1, vnext);
    if (late && pend) { A_PV(vprev); pend = false; }
    if (jt > jmax || done_w) { if (i + 2 < NT) A_LOAD(jt - 2); }
    else {
      const char* Kl = lds + cur * SHMK;
      f32x16 p0, p1;
#pragma unroll
      for (int r = 0; r < 16; ++r) { p0[r] = 0.f; p1[r] = 0.f; }
      {
        bf16x8 kb0[4], kb1[4], qb0[2], qb1[2];
#define QK_LOAD(KB, QB, bt) do { _Pragma("unroll") for (int u_ = 0; u_ < 2; ++u_) { const int d0_ = 2 * (bt) + u_; const int cb_ = (d0_ * 16 + hi * 8) * 2; \
          KB[2 * u_] = *(const bf16x8*)(Kl + KSWZ(r32, cb_)); KB[2 * u_ + 1] = *(const bf16x8*)(Kl + KSWZ(32 + r32, cb_)); \
          if (MLA && d0_ >= 8) QB[u_] = *(const bf16x8*)(qlds + (d0_ - 8) * 1024); else QB[u_] = qr[d0_ < 8 ? d0_ : 0]; } } while (0)
#define QK_MMA(KB, QB) do { _Pragma("unroll") for (int u_ = 0; u_ < 2; ++u_) { \
          p0 = __builtin_amdgcn_mfma_f32_32x32x16_bf16(KB[2 * u_], QB[u_], p0, 0, 0, 0); p1 = __builtin_amdgcn_mfma_f32_32x32x16_bf16(KB[2 * u_ + 1], QB[u_], p1, 0, 0, 0); } } while (0)
        QK_LOAD(kb0, qb0, 0); SBAR();
#pragma unroll
        for (int bt = 0; bt < ND / 2; bt += 2) {
          QK_LOAD(kb1, qb1, bt + 1); SBAR();
          QK_MMA(kb0, qb0); SBAR();
          if (bt + 2 < ND / 2) { QK_LOAD(kb0, qb0, bt + 2); SBAR(); }
          QK_MMA(kb1, qb1); SBAR();
        }
#undef QK_LOAD
#undef QK_MMA
      }
      if (MLA) {
        constexpr float C2 = 0.07216878364870323f * 1.4426950408889634f;
        float pmax = p0[0];
#pragma unroll
        for (int r = 1; r < 16; ++r) pmax = fmaxf(pmax, p0[r]);
#pragma unroll
        for (int r = 0; r < 16; ++r) pmax = fmaxf(pmax, p1[r]);
        { auto rr = __builtin_amdgcn_permlane32_swap(__float_as_uint(pmax), __float_as_uint(pmax), false, false);
          pmax = fmaxf(__uint_as_float(rr[0]), __uint_as_float(rr[1])); }
        float mn, alpha;
        if (__all(pmax - m_reg <= 8.f / 0.07216878364870323f)) { mn = m_reg; alpha = 1.f; }
        else { mn = fmaxf(m_reg, pmax); alpha = __builtin_amdgcn_exp2f((m_reg - mn) * C2); m_reg = mn; }
        const float mnC = -mn * C2;
        float ps = 0.f;
#pragma unroll
        for (int r = 0; r < 16; ++r) { p0[r] = __builtin_amdgcn_exp2f(fmaf(p0[r], C2, mnC)); p1[r] = __builtin_amdgcn_exp2f(fmaf(p1[r], C2, mnC)); ps += p0[r] + p1[r]; }
        { auto rr = __builtin_amdgcn_permlane32_swap(__float_as_uint(ps), __float_as_uint(ps), false, false);
          ps = __uint_as_float(rr[0]) + __uint_as_float(rr[1]); }
        l_reg = l_reg * alpha + ps;
        if (__any(alpha < 1.f)) {
          if (hi == 0) al_l[r32] = alpha;
          asm volatile("s_waitcnt lgkmcnt(0)" ::: "memory");
#pragma unroll
          for (int r = 0; r < 16; ++r) { const float a = al_l[crow(r, hi)];
#pragma unroll
            for (int d = 0; d < 4; ++d) o[d][r] *= a; }
        }
      } else {
        sb_tile(p0, p1, carry, jt == jmax, jt * 64, qrow, hi);
        done_w = __all(carry < 1e-18f);
      }
      PK4(p0, 0, pa0); PK4(p0, 8, pa1); PK4(p1, 0, pa2); PK4(p1, 8, pa3);
      if (i + 2 < NT) A_LOAD(jt - 2);
      if (late) pend = true; else A_PV(vs);
    }
    if (!MLA) { if (lane == 0) dflag[(i & 1) * 8 + wid] = done_w ? 1 : 0; }
    __syncthreads();
    vs = vnext;
    if (!MLA) {
      const int* df = dflag + (i & 1) * 8;
      if ((df[0] & df[1] & df[2] & df[3] & df[4] & df[5] & df[6] & df[7]) != 0) break;
    }
  }
  if (late && pend) { const int vlast = vs == 0 ? 2 : vs - 1; A_PV(vlast); }
  __builtin_amdgcn_s_setprio(0);
  __syncthreads();
  if (MLA) {
    if (hi == 0) li_l[r32] = l_reg;
    asm volatile("s_waitcnt lgkmcnt(0)" ::: "memory");
#pragma unroll
    for (int r = 0; r < 16; ++r) { const float rl = __builtin_amdgcn_rcpf(li_l[crow(r, hi)]);
#pragma unroll
      for (int d = 0; d < 4; ++d) o[d][r] *= rl; }
  }
#pragma unroll
  for (int r = 0; r < 16; ++r) {
    const int orow = q0w + crow(r, hi);
    float s = (o[0][r] * o[0][r] + o[1][r] * o[1][r]) + (o[2][r] * o[2][r] + o[3][r] * o[3][r]);
    s += __shfl_xor(s, 16); s += __shfl_xor(s, 8); s += __shfl_xor(s, 4); s += __shfl_xor(s, 2); s += __shfl_xor(s, 1);
    if (r32 == 0) statb[(size_t)orow * 16] = s;
#pragma unroll
    for (int d = 0; d < 4; ++d) Ob[(size_t)orow * ldo + d * 32 + r32] = (bf16_t)(cvtpk(o[d][r], o[d][r]) & 0xffffu);
  }
#undef A_LOAD
#undef A_WRITE
#undef A_PV
#undef KSWZ
}

struct TrTile { const float* src; bf16_t* dst; const float* g; int K, N, k0, n0, perm; };
DEV TrTile tr_decode(const Params& p, char* ws, int ti) {
  TrTile t; t.g = nullptr; t.perm = 0; int ntn, loc;
  if (ti < 512) { t.src = p.w_in; t.dst = (bf16_t*)(ws + OFF_WIN); t.K = 2048; t.N = INC; ntn = 16; loc = ti; }
  else if (ti < 560) { t.src = p.w_uq; t.dst = (bf16_t*)(ws + OFF_WUQ); t.g = p.g_cq; t.K = 512; t.N = 1536; ntn = 6; loc = ti - 512; }
  else if (ti < 592) { t.src = p.w_ukv; t.dst = (bf16_t*)(ws + OFF_WUKV); t.g = p.g_ckv; t.K = 256; t.N = 2048; ntn = 8; loc = ti - 560; }
  else if (ti < 848) { t.src = p.w_o; t.dst = (bf16_t*)(ws + OFF_WO); t.K = 2048; t.N = 2048; ntn = 8; loc = ti - 592; }
  else if (ti < 2256) { t.src = p.w_up; t.dst = (bf16_t*)(ws + OFF_WUP); t.K = 2048; t.N = DFF2; ntn = 44; loc = ti - 848; t.perm = 1; }
  else { t.src = p.w_down; t.dst = (bf16_t*)(ws + OFF_WDN); t.K = DFF; t.N = 2048; ntn = 8; loc = ti - 2256; }
  const int kt = loc / ntn; t.k0 = kt * 64; t.n0 = (loc % ntn) * 256;
  if (ti >= 592 && ti < 848) t.g = (kt < 16) ? p.g_out_sb : (p.g_out_mla - 1024);
  return t;
}
DEV void tr_load(const TrTile& t, f32x4 (&v)[8], int tid) {
  const int n4 = (tid & 63) * 4, kr = tid >> 6;
#pragma unroll
  for (int i = 0; i < 8; ++i) {
    const int k = kr + 8 * i; v[i] = (f32x4){0.f, 0.f, 0.f, 0.f};
    if (t.n0 + n4 < t.N) v[i] = __builtin_nontemporal_load((const f32x4*)(t.src + (size_t)(t.k0 + k) * t.N + t.n0 + n4));
  }
}
DEV void tr_to_lds(const TrTile& t, const f32x4 (&v)[8], float* tile, int tid) {
  const int n4 = (tid & 63) * 4, kr = tid >> 6;
#pragma unroll
  for (int i = 0; i < 8; ++i) { const int k = kr + 8 * i; f32x4 x = v[i]; if (t.g) x *= t.g[t.k0 + k]; *(f32x4*)(tile + k * 260 + n4) = x; }
}
DEV void tr_store(const TrTile& t, const float* tile, int tid) {
  const int n = tid >> 1, kh = (tid & 1) * 32;
#pragma unroll
  for (int q = 0; q < 4; ++q) {
    u32x4 w;
#pragma unroll
    for (int j = 0; j < 4; ++j) w[j] = cvtpk(tile[(kh + 8 * q + 2 * j) * 260 + n], tile[(kh + 8 * q + 2 * j + 1) * 260 + n]);
    int dn = t.n0 + n;
    if (t.perm) { const int bj = dn >= DFF ? 1 : 0, ch = dn - bj * DFF; dn = (ch >> 7) * 256 + bj * 128 + (ch & 127); }
    *(u32x4*)(t.dst + (size_t)dn * t.K + t.k0 + kh + 8 * q) = w;
  }
}


DEV unsigned long long probe_begin(int k) { return (k == AMP_PHASE) ? __builtin_amdgcn_s_memrealtime() : 0ull; }
DEV void probe_end(int k, unsigned long long t0, const XcdBarrier& xb) {
  if (k == AMP_PHASE) {
    if (blockIdx.x == 0 && threadIdx.x == 0) { const unsigned long long t1 = __builtin_amdgcn_s_memrealtime(); while (__builtin_amdgcn_s_memrealtime() - t1 < (t1 - t0)) __builtin_amdgcn_s_sleep(4); }
    xcd_barrier(xb);
  }
}
__global__ void __launch_bounds__(512, 2) fwd_kernel(Params p) {
  __shared__ __attribute__((aligned(1024))) char shm[135168];
  __shared__ int s_unit;
  __shared__ float rowsc[1024];
  __shared__ __attribute__((aligned(16))) float halo[2048];
  __shared__ uint4 xb_words;
  cg::grid_group grid = cg::this_grid();
  if (threadIdx.x == 0) xb_words = make_uint4(0u, 0u, 0u, 0u);
  __syncthreads();
  unsigned* BAR = (unsigned*)(p.ws + OFF_CNT);
  const XcdBarrier xb = xcd_barrier_post(BAR, (volatile LDS_AS unsigned*)&xb_words);
  if (p.ws == nullptr) grid.sync();
  const int bid = blockIdx.x, nblk = gridDim.x;
  char* ws = p.ws;
  bf16_t* WIN = (bf16_t*)(ws + OFF_WIN); bf16_t* WUQ = (bf16_t*)(ws + OFF_WUQ); bf16_t* WUKV = (bf16_t*)(ws + OFF_WUKV); bf16_t* WO = (bf16_t*)(ws + OFF_WO);
  bf16_t* H = (bf16_t*)(ws + OFF_H); bf16_t* Y = (bf16_t*)(ws + OFF_Y); bf16_t* ACT = (bf16_t*)(ws + OFF_ACT); bf16_t* WUP = (bf16_t*)(ws + OFF_WUP);
  bf16_t* WDN = (bf16_t*)(ws + OFF_WDN); bf16_t* PROJ = (bf16_t*)(ws + OFF_PROJ); bf16_t* Q = (bf16_t*)(ws + OFF_Q);
  bf16_t* KV = (bf16_t*)(ws + OFF_KV); bf16_t* O = (bf16_t*)(ws + OFF_O); bf16_t* Y2 = (bf16_t*)(ws + OFF_Y2);
  float* COS = (float*)(ws + OFF_COS); float* SIN = (float*)(ws + OFF_SIN); float* STC = (float*)(ws + OFF_STC); float* STO = (float*)(ws + OFF_STO);
  float* STY = (float*)(ws + OFF_STY); float* STY2 = (float*)(ws + OFF_STY2); bf16_t* KR = (bf16_t*)(ws + OFF_KR); bf16_t* KSB = (bf16_t*)(ws + OFF_Y); bf16_t* VSB = KSB + (size_t)T_ * 1024; bf16_t* KM = KV; bf16_t* VM = KV + (size_t)T_ * 1024; float* HB = (float*)(ws + OFF_HB); unsigned* CNT = BAR + XB_QCNT;

  const unsigned long long pt0_ = probe_begin(0);
  PH(0) {
    const int tid = opaque_tid(), wid = tid >> 6, lane = tid & 63;
    {
      float* tile = (float*)shm;
      f32x4 v[8]; TrTile tt;
      int ti = bid;
      if (ti < 848) { tt = tr_decode(p, ws, ti); tr_load(tt, v, tid); }
      for (; ti < 848; ti += nblk) {
        tr_to_lds(tt, v, tile, tid);
        __syncthreads();
        const TrTile cur = tt;
        if (ti + nblk < 848) { tt = tr_decode(p, ws, ti + nblk); tr_load(tt, v, tid); }
        tr_store(cur, tile, tid);
        __syncthreads();
      }
    }
    for (int i = 0; i < 4; i += 2) {
      const int tb = bid * 8 + wid + i * 2048;
      f32x4 v[2][8]; float ss[2] = {0.f, 0.f};
#pragma unroll
      for (int q = 0; q < 2; ++q)
#pragma unroll
        for (int j = 0; j < 8; ++j) { v[q][j] = __builtin_nontemporal_load((const f32x4*)(p.x + (size_t)(tb + q * 2048) * DM + j * 256 + lane * 4));
          ss[q] += (v[q][j][0] * v[q][j][0] + v[q][j][1] * v[q][j][1]) + (v[q][j][2] * v[q][j][2] + v[q][j][3] * v[q][j][3]); }
      float r[2];
#pragma unroll
      for (int q = 0; q < 2; ++q) r[q] = rsqrtf(wave_sum(ss[q]) * (1.f / 2048.f) + EPS);
#pragma unroll
      for (int j = 0; j < 8; ++j) { const f32x4 g4 = *(const f32x4*)(p.g_attn_pre + j * 256 + lane * 4);
#pragma unroll
        for (int q = 0; q < 2; ++q) { const f32x4 y = v[q][j] * r[q] * g4;
          u32x2 w; w[0] = cvtpk(y[0], y[1]); w[1] = cvtpk(y[2], y[3]); *(u32x2*)(H + (size_t)(tb + q * 2048) * DM + j * 256 + lane * 4) = w; } }
    }
    for (int idx = bid * 512 + tid; idx < T_ * 32; idx += nblk * 512) {
      const int t = idx >> 5, fi = idx & 31;
      const float inv = exp2f(-(float)fi * (13.287712379549449f / 32.f));
      const float ang = (float)p.pos[t] * inv;
      double rev = (double)ang * 0.15915494309189535; rev -= floor(rev);
      const float rf = (float)rev;
      COS[idx] = __builtin_amdgcn_cosf(rf); SIN[idx] = __builtin_amdgcn_sinf(rf);
    }
  }
  xcd_barrier(xb);
  probe_end(0, pt0_, xb);
  for (int es_ = 0; es_ < EXTRA_SYNC; ++es_) xcd_barrier(xb);
  const unsigned long long pt1_ = probe_begin(1);
  PH(1) { Epi<0> e; e.outK = KSB; e.outV = VSB; e.out = PROJ; e.ldo = INP; e.st_in = nullptr; e.st_out = STC;
    gemm_phase<0>(shm, rowsc, H, DM, WIN, 2048, 16, e); }
  xcd_barrier(xb);
  probe_end(1, pt1_, xb);
  const unsigned long long pt2_ = probe_begin(2);
  PH(2) {
    for (int idx = bid * 512 + opaque_tid(); idx < T_ * 32; idx += nblk * 512) {
      const int t = idx >> 5, i = idx & 31;
      const float x1 = __uint_as_float((unsigned)PROJ[(size_t)t * INP + 3840 + i] << 16), x2 = __uint_as_float((unsigned)PROJ[(size_t)t * INP + 3872 + i] << 16);
      const float c = COS[idx], sn = SIN[idx];
      KR[(size_t)t * 64 + i] = (bf16_t)(cvtpk(x1 * c - x2 * sn, 0.f) & 0xffffu); KR[(size_t)t * 64 + 32 + i] = (bf16_t)(cvtpk(x1 * sn + x2 * c, 0.f) & 0xffffu);
    }
    Epi<1> e; e.out = Q; e.ldo = 1536; e.st_in = STC; e.st_out = nullptr;
    gemm_phase<1>(shm, rowsc, PROJ + 3072, INP, WUQ, 512, 6, e);
    Epi<2> e2; e2.outK = KM; e2.outV = VM; e2.out = KV; e2.ldo = 2048; e2.st_in = STC; e2.st_out = nullptr;
    gemm_phase<2>(shm, rowsc, PROJ + 3584, INP, WUKV, 256, 8, e2); }
  xcd_barrier(xb);
  probe_end(2, pt2_, xb);
  const unsigned long long pt3_ = probe_begin(3);
  PH(3) for (int first_ = 1;; first_ = 0) {
    const int tid = opaque_tid();
    int u;
    if (first_) u = bid;
    else {
      if (tid == 0) s_unit = 256 + (int)atomicAdd(CNT, 1u);
      __syncthreads();
      u = s_unit;
      __syncthreads();
    }
    if (u >= 512 + 352) break;
    if (u >= 512) {
      float* tile = (float*)shm; f32x4 v[8]; TrTile tt;
      int ti = 848 + 4 * (u - 512); const int te = ti + 4;
      tt = tr_decode(p, ws, ti); tr_load(tt, v, tid);
      for (; ti < te; ++ti) {
        tr_to_lds(tt, v, tile, tid);
        __syncthreads();
        const TrTile cur = tt;
        if (ti + 1 < te) { tt = tr_decode(p, ws, ti + 1); tr_load(tt, v, tid); }
        tr_store(cur, tile, tid);
        __syncthreads();
      }
      continue;
    }
    const int mla = u < 256 ? 1 : 0, v_ = u & 255, qb = 7 - (v_ >> 5), b = (v_ & 31) >> 3, h = v_ & 7;
    const size_t r0 = (size_t)b * SEQ;
    if (mla) attn_unit<true>(shm, Q + r0 * 1536 + h * 192, 1536, KM + ((size_t)(b * 8 + h) * 2048) * 128, 128, KR + r0 * 64, 64, VM + ((size_t)(b * 8 + h) * 2048) * 128, 128,
                             O + r0 * 2048 + 1024 + h * 128, 2048, STO + r0 * 16 + 8 + h, qb, COS + r0 * 32, SIN + r0 * 32);
    else attn_unit<false>(shm, PROJ + r0 * INP + h * 128, INP, KSB + ((size_t)(b * 8 + h) * 2048) * 128, 128, nullptr, 0, VSB + ((size_t)(b * 8 + h) * 2048) * 128, 128,
                          O + r0 * 2048 + h * 128, 2048, STO + r0 * 16 + h, qb, nullptr, nullptr);
  }
  xcd_barrier(xb);
  probe_end(3, pt3_, xb);
  const unsigned long long pt4_ = probe_begin(4);
  PH(4) { Epi<3> e; e.out = Y; e.ldo = 2048; e.st_in = STO; e.st_out = STY;
    gemm_phase<3>(shm, rowsc, O, 2048, WO, 2048, 8, e); }
  xcd_barrier(xb);
  probe_end(4, pt4_, xb);
  const unsigned long long pt5_ = probe_begin(5);
  PH(5) for (int i = 0; i < 4; i += 2) {
    const int tid = opaque_tid(), wid = tid >> 6, lane = tid & 63;
    const int tb = bid * 8 + wid + i * 2048;
    float r[2]; f32x4 x1[2][4][2]; float ss[2];
#pragma unroll
    for (int q = 0; q < 2; ++q) {
      float s = STY[(size_t)(tb + q * 2048) * 32 + (lane & 31)];
      s += __shfl_xor(s, 16); s += __shfl_xor(s, 8); s += __shfl_xor(s, 4); s += __shfl_xor(s, 2); s += __shfl_xor(s, 1);
      r[q] = rsqrtf(s * (1.f / 2048.f) + EPS); ss[q] = 0.f;
    }
#pragma unroll
    for (int j = 0; j < 4; ++j) {
      const int c = j * 512 + lane * 8;
      const f32x4 ga = *(const f32x4*)(p.g_attn_post + c), gb = *(const f32x4*)(p.g_attn_post + c + 4);
#pragma unroll
      for (int q = 0; q < 2; ++q) {
        const size_t ro = (size_t)(tb + q * 2048) * DM + c;
        const u32x4 yw = *(const u32x4*)(Y + ro);
        const f32x4 xa = __builtin_nontemporal_load((const f32x4*)(p.x + ro)), xb2 = __builtin_nontemporal_load((const f32x4*)(p.x + ro + 4));
        const f32x4 ya = {bf_lo(yw[0]), bf_hi(yw[0]), bf_lo(yw[1]), bf_hi(yw[1])}, yb = {bf_lo(yw[2]), bf_hi(yw[2]), bf_lo(yw[3]), bf_hi(yw[3])};
        x1[q][j][0] = xa + ya * r[q] * ga; x1[q][j][1] = xb2 + yb * r[q] * gb;
        { u32x4 xw; xw[0] = cvtpk(x1[q][j][0][0], x1[q][j][0][1]); xw[1] = cvtpk(x1[q][j][0][2], x1[q][j][0][3]); xw[2] = cvtpk(x1[q][j][1][0], x1[q][j][1][1]); xw[3] = cvtpk(x1[q][j][1][2], x1[q][j][1][3]);
          *(u32x4*)(Y + ro) = xw; }
#pragma unroll
        for (int h = 0; h < 2; ++h) ss[q] += (x1[q][j][h][0] * x1[q][j][h][0] + x1[q][j][h][1] * x1[q][j][h][1]) + (x1[q][j][h][2] * x1[q][j][h][2] + x1[q][j][h][3] * x1[q][j][h][3]);
      }
    }
    float r2[2];
#pragma unroll
    for (int q = 0; q < 2; ++q) r2[q] = rsqrtf(wave_sum(ss[q]) * (1.f / 2048.f) + EPS);
#pragma unroll
    for (int j = 0; j < 4; ++j) {
      const int c = j * 512 + lane * 8;
      const f32x4 ga = *(const f32x4*)(p.g_ffn_pre + c), gb = *(const f32x4*)(p.g_ffn_pre + c + 4);
#pragma unroll
      for (int q = 0; q < 2; ++q) {
        const f32x4 ha = x1[q][j][0] * r2[q] * ga, hb = x1[q][j][1] * r2[q] * gb;
        u32x4 w; w[0] = cvtpk(ha[0], ha[1]); w[1] = cvtpk(ha[2], ha[3]); w[2] = cvtpk(hb[0], hb[1]); w[3] = cvtpk(hb[2], hb[3]);
        *(u32x4*)(H + (size_t)(tb + q * 2048) * DM + c) = w;
      }
    }
  }
  xcd_barrier(xb);
  probe_end(5, pt5_, xb);
  const unsigned long long pt6_ = probe_begin(6);
  PH(6) { Epi<4> e; e.out = ACT; e.ldo = DFF; e.st_in = nullptr; e.st_out = nullptr;
    gemm_phase<4>(shm, rowsc, H, DM, WUP, 2048, 44, e, halo, HB, p.conv_w, p.conv_b);
    if (bid >= 128) {
      const int tid = opaque_tid(); float* tile = (float*)shm; f32x4 v[8]; TrTile tt;
      int ti = 2256 + (bid - 128);
      if (ti < 2960) { tt = tr_decode(p, ws, ti); tr_load(tt, v, tid); }
      for (; ti < 2960; ti += 128) {
        tr_to_lds(tt, v, tile, tid);
        __syncthreads();
        const TrTile cur = tt;
        if (ti + 128 < 2960) { tt = tr_decode(p, ws, ti + 128); tr_load(tt, v, tid); }
        tr_store(cur, tile, tid);
        __syncthreads();
      }
    } }
  xcd_barrier(xb);
  probe_end(6, pt6_, xb);
  const unsigned long long pt7_ = probe_begin(7);
  PH(7) for (int it = bid * 512 + opaque_tid(); it < 28 * 2 * 1408; it += nblk * 512) {
    const int c4 = it % 1408, rs = (it / 1408) & 1, pmi = it / 2816, pm = (pmi / 7) * 8 + (pmi % 7) + 1, ch = c4 * 4;
    const int colg = (ch >> 7) * 256 + (ch & 127), colv = colg + 128;
    const float* h0 = HB + (size_t)((pm - 1) * 4) * DFF2; const float* h1 = HB + (size_t)(pm * 4) * DFF2;
    const f32x4 gm2 = *(const f32x4*)(h0 + colg), gm1 = *(const f32x4*)(h0 + DFF2 + colg), g0 = *(const f32x4*)(h1 + 2 * DFF2 + colg), g1 = *(const f32x4*)(h1 + 3 * DFF2 + colg);
    const f32x4 vm2 = *(const f32x4*)(h0 + colv), vm1 = *(const f32x4*)(h0 + DFF2 + colv), v0 = *(const f32x4*)(h1 + 2 * DFF2 + colv), v1 = *(const f32x4*)(h1 + 3 * DFF2 + colv);
    const f32x4 cg = rs ? g1 : g0, pg1 = rs ? g0 : gm1, pg2 = rs ? gm1 : gm2, cv = rs ? v1 : v0, pv1 = rs ? v0 : vm1, pv2 = rs ? vm1 : vm2;
    const f32x4 wg0 = *(const f32x4*)(p.conv_w + ch), wg1 = *(const f32x4*)(p.conv_w + DFF2 + ch), wg2 = *(const f32x4*)(p.conv_w + 2 * DFF2 + ch), bg = *(const f32x4*)(p.conv_b + ch);
    const f32x4 wv0 = *(const f32x4*)(p.conv_w + DFF + ch), wv1 = *(const f32x4*)(p.conv_w + DFF2 + DFF + ch), wv2 = *(const f32x4*)(p.conv_w + 2 * DFF2 + DFF + ch), bv = *(const f32x4*)(p.conv_b + DFF + ch);
    const f32x4 ug = wg2 * cg + wg1 * pg1 + wg0 * pg2 + bg, uv = wv2 * cv + wv1 * pv1 + wv0 * pv2 + bv;
    u32x2 w; w[0] = cvtpk(gelu_tanh(ug[0]) * uv[0], gelu_tanh(ug[1]) * uv[1]); w[1] = cvtpk(gelu_tanh(ug[2]) * uv[2], gelu_tanh(ug[3]) * uv[3]);
    *(u32x2*)(ACT + (size_t)(pm * 256 + rs) * DFF + ch) = w;
  }
  xcd_barrier(xb);
  probe_end(7, pt7_, xb);
  const unsigned long long pt8_ = probe_begin(8);
  PH(8) { Epi<5> e; e.out = Y2; e.ldo = 2048; e.st_in = nullptr; e.st_out = STY2;
    gemm_phase<5>(shm, rowsc, ACT, DFF, WDN, DFF, 8, e); }
  xcd_barrier(xb);
  probe_end(8, pt8_, xb);
  const unsigned long long pt9_ = probe_begin(9);
  PH(9) {
    const int tid = opaque_tid(), wid = tid >> 6, lane = tid & 63;
    const int tb = bid * 8 + wid;
    float r[4];
#pragma unroll
    for (int q = 0; q < 4; ++q) {
      float s = STY2[(size_t)(tb + q * 2048) * 32 + (lane & 31)];
      s += __shfl_xor(s, 16); s += __shfl_xor(s, 8); s += __shfl_xor(s, 4); s += __shfl_xor(s, 2); s += __shfl_xor(s, 1);
      r[q] = rsqrtf(s * (1.f / 2048.f) + EPS);
    }
#pragma unroll
    for (int j = 0; j < 4; ++j) {
      const int c = j * 512 + lane * 8;
      const f32x4 ga = *(const f32x4*)(p.g_ffn_post + c), gb = *(const f32x4*)(p.g_ffn_post + c + 4);
#pragma unroll
      for (int q = 0; q < 4; ++q) {
        const size_t ro = (size_t)(tb + q * 2048) * DM + c;
        const u32x4 yw = *(const u32x4*)(Y2 + ro);
        const u32x4 xw = *(const u32x4*)(Y + ro);
        const f32x4 xa = {bf_lo(xw[0]), bf_hi(xw[0]), bf_lo(xw[1]), bf_hi(xw[1])}, xb2 = {bf_lo(xw[2]), bf_hi(xw[2]), bf_lo(xw[3]), bf_hi(xw[3])};
        const f32x4 ya = {bf_lo(yw[0]), bf_hi(yw[0]), bf_lo(yw[1]), bf_hi(yw[1])}, yb = {bf_lo(yw[2]), bf_hi(yw[2]), bf_lo(yw[3]), bf_hi(yw[3])};
        __builtin_nontemporal_store(xa + ya * r[q] * ga, (f32x4*)(p.out + ro)); __builtin_nontemporal_store(xb2 + yb * r[q] * gb, (f32x4*)(p.out + ro + 4));
      }
    }
  }
}

extern "C" void kernel_launch(void* const* d_in, const int* in_sizes, int n_in, void* d_out, int out_size, void* d_ws, size_t ws_size, hipStream_t stream) {
  if (n_in != 18 || ws_size < WS_END) { fprintf(stderr, "kernel_launch: unexpected n_in %d / ws_size %zu (need %zu)\n", n_in, ws_size, (size_t)WS_END); return; }
  static int grid_blocks = 0;
  if (!grid_blocks) {
    int dev = 0, cus = 0, per_cu = 0;
    (void)hipGetDevice(&dev);
    (void)hipDeviceGetAttribute(&cus, hipDeviceAttributeMultiprocessorCount, dev);
    (void)hipOccupancyMaxActiveBlocksPerMultiprocessor(&per_cu, fwd_kernel, 512, 0);
    if (per_cu < 1) per_cu = 1;
    grid_blocks = 256;
  }
  Params p{};
  p.x = (const float*)d_in[0]; p.pos = (const int*)d_in[1]; p.g_attn_pre = (const float*)d_in[2]; p.w_in = (const float*)d_in[3]; p.g_cq = (const float*)d_in[4];
  p.w_uq = (const float*)d_in[5]; p.g_ckv = (const float*)d_in[6]; p.w_ukv = (const float*)d_in[7]; p.g_out_sb = (const float*)d_in[8]; p.g_out_mla = (const float*)d_in[9];
  p.w_o = (const float*)d_in[10]; p.g_attn_post = (const float*)d_in[11]; p.g_ffn_pre = (const float*)d_in[12]; p.w_up = (const float*)d_in[13]; p.conv_w = (const float*)d_in[14];
  p.conv_b = (const float*)d_in[15]; p.w_down = (const float*)d_in[16]; p.g_ffn_post = (const float*)d_in[17]; p.out = (float*)d_out; p.ws = (char*)d_ws;
  (void)hipMemsetAsync((char*)d_ws + OFF_CNT, 0, 16384, stream);
  void* args[] = {&p};
  hipError_t e = hipLaunchCooperativeKernel((void*)fwd_kernel, dim3(grid_blocks), dim3(512), args, 0, stream);
  if (e != hipSuccess) fprintf(stderr, "cooperative launch failed: %s (grid %d)\n", hipGetErrorString(e), grid_blocks);
}
```

```cpp
#include <hip/hip_runtime.h>
#include <hip/hip_bf16.h>
#include <hip/hip_cooperative_groups.h>
#include <cstdio>
#include <cstdint>
namespace cg = cooperative_groups;

typedef unsigned short bf16_t;
using bf16x8 = __attribute__((ext_vector_type(8))) short;
using s16x4  = __attribute__((ext_vector_type(4))) short;
using f32x4  = __attribute__((ext_vector_type(4))) float;
using f32x16 = __attribute__((ext_vector_type(16))) float;
using u32x4  = __attribute__((ext_vector_type(4))) unsigned;
using u32x2  = __attribute__((ext_vector_type(2))) unsigned;
using i32x4  = __attribute__((ext_vector_type(4))) int;
#define DEV __device__ __forceinline__
#define LDS_AS __attribute__((address_space(3)))
#define GLB_AS __attribute__((address_space(1)))
#define SBAR() __builtin_amdgcn_sched_barrier(0)

constexpr int T_ = 8192, DM = 2048, SEQ = 2048;
constexpr int INC = 3904, INP = 4096, DFF = 5632, DFF2 = 11264;
constexpr float EPS = 1e-6f;
#ifndef PHASES
#define PHASES 0x3ff
#endif
#ifndef REPMASK
#define REPMASK 0
#endif
#define EXTRA_SYNC 0
#define AMP_PHASE -1
#define PH(k) if constexpr ((PHASES >> (k)) & 1) for (int rep_ = 0; rep_ < 1 + ((REPMASK >> (k)) & 1); ++rep_)
constexpr size_t MiB = 1024 * 1024;
constexpr size_t OFF_WIN = 0, OFF_WUQ = 16 * MiB, OFF_WUKV = OFF_WUQ + 3 * MiB / 2, OFF_WO = OFF_WUKV + MiB, OFF_H = OFF_WO + 8 * MiB,
                 OFF_Y = OFF_H + 32 * MiB, OFF_WUP = OFF_Y + 32 * MiB, OFF_WDN = OFF_WUP + 44 * MiB, OFF_UP = OFF_WDN + 22 * MiB,
                 OFF_PROJ = OFF_UP, OFF_Q = OFF_UP + 64 * MiB, OFF_KV = OFF_Q + 24 * MiB, OFF_O = OFF_KV + 32 * MiB, OFF_ACT = OFF_UP, OFF_Y2 = OFF_UP + 88 * MiB, OFF_HB = OFF_UP + 120 * MiB,
                 OFF_COS = OFF_UP + 176 * MiB, OFF_SIN = OFF_COS + MiB, OFF_STC = OFF_SIN + MiB, OFF_STO = OFF_STC + MiB / 2,
                 OFF_STY = OFF_STO + MiB / 2, OFF_STY2 = OFF_STY + MiB, OFF_KR = OFF_STY2 + MiB, OFF_CNT = OFF_KR + MiB, WS_END = OFF_CNT + 16384;

struct Params {
  const float* x; const int* pos; const float* g_attn_pre; const float* w_in; const float* g_cq; const float* w_uq; const float* g_ckv; const float* w_ukv;
  const float* g_out_sb; const float* g_out_mla; const float* w_o; const float* g_attn_post; const float* g_ffn_pre; const float* w_up; const float* conv_w;
  const float* conv_b; const float* w_down; const float* g_ffn_post; float* out; char* ws;
};

DEV unsigned cvtpk(float lo, float hi) { unsigned r; asm volatile("v_cvt_pk_bf16_f32 %0, %1, %2" : "=v"(r) : "v"(lo), "v"(hi)); return r; }
DEV float bf_lo(unsigned w) { return __uint_as_float(w << 16); }
DEV float bf_hi(unsigned w) { return __uint_as_float(w & 0xffff0000u); }
DEV int crow(int r, int hi) { return (r & 3) + 8 * (r >> 2) + 4 * hi; }
DEV int opaque_tid() { int t = threadIdx.x; asm volatile("" : "+v"(t)); return t; }
DEV float wave_sum(float s) {
  s += __shfl_xor(s, 32); s += __shfl_xor(s, 16); s += __shfl_xor(s, 8); s += __shfl_xor(s, 4); s += __shfl_xor(s, 2); s += __shfl_xor(s, 1); return s;
}

DEV const char* uptr(const void* p) {
  const unsigned long long v = (unsigned long long)p;
  const unsigned lo = __builtin_amdgcn_readfirstlane((unsigned)v), hi = __builtin_amdgcn_readfirstlane((unsigned)(v >> 32));
  return (const char*)(((unsigned long long)hi << 32) | lo);
}

#define XB_TMO      128
#define XB_XCNT(j)  (256  + 64 * (j))
#define XB_XSUB(j)  (1280 + 64 * (j))
#define XB_XGEN(j)  (2304 + 64 * (j))
#define XB_TOP      3328
#define XB_TOPGEN   3392
#define XB_QCNT     3456
#define XCD_BAR_WORDS 3520
#define XB_SPIN_CAP (1u << 18)
DEV unsigned xb_ld(unsigned* p)              { return __hip_atomic_load(p, __ATOMIC_RELAXED, __HIP_MEMORY_SCOPE_AGENT); }
DEV unsigned xb_add(unsigned* p, unsigned v) { return __hip_atomic_fetch_add(p, v, __ATOMIC_RELAXED, __HIP_MEMORY_SCOPE_AGENT); }
DEV unsigned xb_xcc_id() { return (unsigned)__builtin_amdgcn_s_getreg((3 << 11) | 20) & 0xFu; }
#define XB_SPIN(cond, bar) do { unsigned _sp = 0; while (cond) { __builtin_amdgcn_s_sleep(1); \
    if ((++_sp & 255u) == 0u) { if (xb_ld(&(bar)[XB_TMO])) break; if (_sp > XB_SPIN_CAP) { atomicAdd(&(bar)[XB_TMO], 1u); break; } } } } while (0)
struct XcdBarrier { unsigned* bar; unsigned x; volatile LDS_AS unsigned* st; };
DEV XcdBarrier xcd_barrier_post(unsigned* bar, volatile LDS_AS unsigned* st) {
  XcdBarrier b; b.bar = bar; b.x = xb_xcc_id(); b.st = st;
  if (threadIdx.x == 0) (void)xb_add(&bar[XB_XCNT(b.x)], 1u);
  return b;
}
DEV void xcd_barrier_complete(unsigned* bar, unsigned x, unsigned& nloc, unsigned& nx) {
  const unsigned G = gridDim.x * gridDim.y * gridDim.z;
  unsigned sum, cnt, mine, sp = 0u;
  for (;;) {
    sum = 0u; cnt = 0u; mine = 0u;
#pragma unroll
    for (unsigned j = 0; j < 16; ++j) { const unsigned c = xb_ld(&bar[XB_XCNT(j)]); sum += c; cnt += (c > 0u) ? 1u : 0u; mine = (j == x) ? c : mine; }
    if (sum == G) break;
    __builtin_amdgcn_s_sleep(1);
    if ((++sp & 255u) == 0u) { if (xb_ld(&bar[XB_TMO])) break; if (sp > XB_SPIN_CAP) { atomicAdd(&bar[XB_TMO], 1u); break; } }
  }
  nloc = mine > 0u ? mine : 1u; nx = cnt > 0u ? cnt : 1u;
}
DEV void xcd_barrier(const XcdBarrier& b) {
  asm volatile("s_waitcnt vmcnt(0)" ::: "memory");
  __syncthreads();
  if (threadIdx.x == 0) {
    unsigned* bar = b.bar;
    __builtin_amdgcn_s_waitcnt(0);
    unsigned nloc = b.st[0], nx = b.st[1];
    if (nloc == 0u) { xcd_barrier_complete(bar, b.x, nloc, nx); b.st[0] = nloc; b.st[1] = nx; }
    const unsigned old = xb_add(&bar[XB_XSUB(b.x)], 1u);
    const unsigned gen = old / nloc;
    if (old + 1u == (gen + 1u) * nloc) {
      __builtin_amdgcn_fence(__ATOMIC_RELEASE, "agent");
      asm volatile("s_waitcnt vmcnt(0)" ::: "memory");
      const unsigned og = xb_add(&bar[XB_TOP], 1u);
      const unsigned tg = og / nx;
      if (og + 1u == (tg + 1u) * nx) xb_add(&bar[XB_TOPGEN], 1u);
      else XB_SPIN(xb_ld(&bar[XB_TOPGEN]) == tg, bar);
      __builtin_amdgcn_fence(__ATOMIC_ACQUIRE, "agent");
      xb_add(&bar[XB_XGEN(b.x)], 1u);
      asm volatile("s_waitcnt vmcnt(0)" ::: "memory");
    } else {
      XB_SPIN(xb_ld(&bar[XB_XGEN(b.x)]) == gen, bar);
      __builtin_amdgcn_fence(__ATOMIC_ACQUIRE, "agent");
      asm volatile("s_waitcnt vmcnt(0)" ::: "memory");
    }
  }
  __syncthreads();
}
DEV int lds_byte2(int r, int c) { int st = (r >> 4) * 2 + (c >> 5), ob = (r & 15) * 64 + (c & 31) * 2; return st * 1024 + (ob ^ (((ob >> 9) & 1) << 5)); }
DEV void stage_rc2(int b, int& R, int& C) { int st = b >> 10, sb = b & 1023, swz = sb ^ (((sb >> 9) & 1) << 5); R = (st >> 1) * 16 + swz / 64; C = (st & 1) * 32 + (swz % 64) / 2; }

DEV float gelu_tanh(float x) {
  const float u = x + 0.044715f * x * x * x;
  return x * __builtin_amdgcn_rcpf(1.f + __builtin_amdgcn_exp2f(-2.302208198f * u));
}

DEV float dpp_shr1(float old, float src) {
  return __int_as_float(__builtin_amdgcn_update_dpp(__float_as_int(old), __float_as_int(src), 0x111, 0xf, 0xf, false));
}
DEV void epi_up(const f32x4 (&acc)[2][2][4][2], int pm, int pn, int wr, int wc, int fr, int fq, float* halo, bf16_t* ACTp, float* HB, const float* conv_w, const float* conv_b) {
  if (fr == 15) {
#pragma unroll
    for (int ai = 0; ai < 2; ++ai)
#pragma unroll
      for (int rs = 0; rs < 2; ++rs)
#pragma unroll
        for (int bj = 0; bj < 2; ++bj)
#pragma unroll
          for (int n = 0; n < 2; ++n) *(f32x4*)(halo + (((ai * 2 + wr) * 4 + wc) * 2 + rs) * 64 + (bj * 2 + n) * 16 + fq * 4) = acc[ai][bj][2 + rs][n];
  }
  {
    GLB_AS char* hb = (GLB_AS char*)uptr(HB);
    if (wr == 1 && fr == 15) {
#pragma unroll
      for (int rs = 0; rs < 2; ++rs)
#pragma unroll
        for (int bj = 0; bj < 2; ++bj)
#pragma unroll
          for (int n = 0; n < 2; ++n) *(GLB_AS f32x4*)(hb + (unsigned)((pm * 4 + rs) * DFF2 + pn * 256 + bj * 128 + wc * 32 + 8 * fq + 4 * n) * 4u) = acc[1][bj][2 + rs][n];
    }
    if (wr == 0 && fr == 0) {
#pragma unroll
      for (int rs = 0; rs < 2; ++rs)
#pragma unroll
        for (int bj = 0; bj < 2; ++bj)
#pragma unroll
          for (int n = 0; n < 2; ++n) *(GLB_AS f32x4*)(hb + (unsigned)((pm * 4 + 2 + rs) * DFF2 + pn * 256 + bj * 128 + wc * 32 + 8 * fq + 4 * n) * 4u) = acc[0][bj][rs][n];
    }
  }
  asm volatile("s_waitcnt lgkmcnt(0)" ::: "memory"); __builtin_amdgcn_s_barrier(); asm volatile("" ::: "memory");
  GLB_AS char* ap = (GLB_AS char*)uptr(ACTp);
#pragma unroll
  for (int n = 0; n < 2; ++n) {
    const int chb = pn * 128 + wc * 32 + 8 * fq + 4 * n;
    const f32x4 wg0 = *(const f32x4*)(conv_w + chb), wg1 = *(const f32x4*)(conv_w + DFF2 + chb), wg2 = *(const f32x4*)(conv_w + 2 * DFF2 + chb), bg = *(const f32x4*)(conv_b + chb);
    const f32x4 wv0 = *(const f32x4*)(conv_w + DFF + chb), wv1 = *(const f32x4*)(conv_w + DFF2 + DFF + chb), wv2 = *(const f32x4*)(conv_w + 2 * DFF2 + DFF + chb), bv = *(const f32x4*)(conv_b + DFF + chb);
#pragma unroll
    for (int ai = 0; ai < 2; ++ai) {
      f32x4 hg2 = {0.f, 0.f, 0.f, 0.f}, hg3 = hg2, hv2 = hg2, hv3 = hg2;
      if ((wr == 1 || ai == 1) && fr == 0) {
        const int sai = wr == 1 ? ai : 0, swr = wr == 1 ? 0 : 1;
        const float* hp = halo + ((sai * 2 + swr) * 4 + wc) * 128 + fq * 4;
        hg2 = *(const f32x4*)(hp + n * 16); hv2 = *(const f32x4*)(hp + (2 + n) * 16); hg3 = *(const f32x4*)(hp + 64 + n * 16); hv3 = *(const f32x4*)(hp + 64 + (2 + n) * 16);
      }
      f32x4 sg2, sg3, sv2, sv3;
#pragma unroll
      for (int j = 0; j < 4; ++j) {
        sg2[j] = dpp_shr1(hg2[j], acc[ai][0][2][n][j]); sg3[j] = dpp_shr1(hg3[j], acc[ai][0][3][n][j]);
        sv2[j] = dpp_shr1(hv2[j], acc[ai][1][2][n][j]); sv3[j] = dpp_shr1(hv3[j], acc[ai][1][3][n][j]);
      }
#pragma unroll
      for (int m = 0; m < 4; ++m) {
        const f32x4 cg = acc[ai][0][m][n], cv = acc[ai][1][m][n];
        const f32x4 g1 = m == 0 ? sg3 : acc[ai][0][m == 0 ? 0 : m - 1][n], g2 = m == 0 ? sg2 : (m == 1 ? sg3 : acc[ai][0][m < 2 ? 0 : m - 2][n]);
        const f32x4 v1 = m == 0 ? sv3 : acc[ai][1][m == 0 ? 0 : m - 1][n], v2 = m == 0 ? sv2 : (m == 1 ? sv3 : acc[ai][1][m < 2 ? 0 : m - 2][n]);
        const f32x4 ug = wg2 * cg + wg1 * g1 + wg0 * g2 + bg, uv = wv2 * cv + wv1 * v1 + wv0 * v2 + bv;
        const int row = pm * 256 + ai * 128 + wr * 64 + 4 * fr + m;
        u32x2 w; w[0] = cvtpk(gelu_tanh(ug[0]) * uv[0], gelu_tanh(ug[1]) * uv[1]); w[1] = cvtpk(gelu_tanh(ug[2]) * uv[2], gelu_tanh(ug[3]) * uv[3]);
        *(GLB_AS u32x2*)(ap + (unsigned)(row * DFF + chb) * 2u) = w;
      }
      asm volatile("" ::: "memory");
    }
  }
}

DEV int perm32(int rho) { const int n = rho >> 4, i = rho & 15; return 8 * (i >> 2) + 4 * n + (i & 3); }
struct Unit { int pm, pn; };
struct Sched {
  int nN, nUnits, G, c;
  DEV bool next(int i, Unit& u) const { const int L = i * G + c; if (L >= nUnits) return false; u.pm = (L & 15) + 16 * (L / (16 * nN)); u.pn = (L >> 4) % nN; return true; }
};
template <int MODE> struct Epi {
  bf16_t* out; int ldo; const float* st_in; float* st_out; bf16_t* outK; bf16_t* outV;
  DEV void prep(float* rsc, int row0, int tid) const {
    if (tid < 256) {
      const float* sp = st_in + (size_t)(row0 + tid) * 16;
      const f32x4 a0 = *(const f32x4*)(sp), a1 = *(const f32x4*)(sp + 4), b0 = *(const f32x4*)(sp + 8), b1 = *(const f32x4*)(sp + 12);
      const float ssb = (a0[0] + a0[1]) + (a0[2] + a0[3]) + (a1[0] + a1[1]) + (a1[2] + a1[3]);
      const float sml = (b0[0] + b0[1]) + (b0[2] + b0[3]) + (b1[0] + b1[1]) + (b1[2] + b1[3]);
      const float rsb = rsqrtf(ssb * (1.f / 1024.f) + EPS), rml = rsqrtf(sml * (1.f / 1024.f) + EPS);
      rsc[tid] = rsb / rml; rsc[256 + tid] = rml;
    }
  }
  DEV void hook(f32x4 (&acc)[2][2][4][2], const float* rsc, int wr, int fr) const {
#pragma unroll
    for (int ai = 0; ai < 2; ++ai)
#pragma unroll
      for (int m = 0; m < 4; ++m) {
        const float ratio = rsc[ai * 128 + wr * 64 + m * 16 + fr];
#pragma unroll
        for (int bj = 0; bj < 2; ++bj)
#pragma unroll
          for (int n = 0; n < 2; ++n) acc[ai][bj][m][n] *= ratio;
      }
  }
  DEV void operator()(const f32x4 (&acc)[2][2][4][2], int pm, int pn, int wr, int wc, int fr, int fq, const float* rsc) const {
    const bool do_stat = MODE == 0 ? (pn >= 12 && pn < 15) : (MODE == 3 || MODE == 5);
    const int slot = MODE == 0 ? ((pn - 12) * 4 + wc) : (pn * 4 + wc);
    constexpr int SS = MODE == 0 ? 16 : 32;
    GLB_AS char* ob = (GLB_AS char*)uptr(out);
#pragma unroll
    for (int ai = 0; ai < 2; ++ai)
#pragma unroll
      for (int m = 0; m < 4; ++m) {
        const int rloc = ai * 128 + wr * 64 + m * 16 + fr, row = pm * 256 + rloc;
        float rs = (MODE == 0 && pn < 4) ? 0.08838834764831845f * 1.4426950408889634f : 1.f;
        if (MODE == 1) { const float* sp = st_in + (size_t)row * 16; const f32x4 a0 = *(const f32x4*)(sp), a1 = *(const f32x4*)(sp + 4);
          rs = rsqrtf(((a0[0] + a0[1]) + (a0[2] + a0[3]) + (a1[0] + a1[1]) + (a1[2] + a1[3])) * (1.f / 512.f) + EPS); }
        if (MODE == 2) { const f32x4 a0 = *(const f32x4*)(st_in + (size_t)row * 16 + 8); rs = rsqrtf(((a0[0] + a0[1]) + (a0[2] + a0[3])) * (1.f / 256.f) + EPS); }
        if (MODE == 3) rs = rsc[256 + rloc];
        f32x4 v[2][2];
#pragma unroll
        for (int bj = 0; bj < 2; ++bj)
#pragma unroll
          for (int n = 0; n < 2; ++n) v[bj][n] = acc[ai][bj][m][n] * rs;
        if (MODE == 0 || MODE == 3 || MODE == 5) {
          if (do_stat) {
            float s = 0.f;
#pragma unroll
            for (int bj = 0; bj < 2; ++bj)
#pragma unroll
              for (int n = 0; n < 2; ++n) s += (v[bj][n][0] * v[bj][n][0] + v[bj][n][1] * v[bj][n][1]) + (v[bj][n][2] * v[bj][n][2] + v[bj][n][3] * v[bj][n][3]);
            s += __shfl_xor(s, 16); s += __shfl_xor(s, 32);
            *(GLB_AS float*)((GLB_AS char*)uptr(st_out) + (unsigned)(row * SS + slot) * 4u) = s;
          }
        }
        u32x4 w[2];
#pragma unroll
        for (int bj = 0; bj < 2; ++bj) { w[bj][0] = cvtpk(v[bj][0][0], v[bj][0][1]); w[bj][1] = cvtpk(v[bj][0][2], v[bj][0][3]); w[bj][2] = cvtpk(v[bj][1][0], v[bj][1][1]); w[bj][3] = cvtpk(v[bj][1][2], v[bj][1][3]); }
        if (MODE == 0 && pn >= 4 && pn < 12) {
          GLB_AS char* hb_ = (GLB_AS char*)uptr(pn < 8 ? outK : outV);
#pragma unroll
          for (int bj = 0; bj < 2; ++bj) { const int hh = (pn & 3) * 2 + bj;
            *(GLB_AS u32x4*)(hb_ + (unsigned)((((row >> 11) * 8 + hh) * 2048 + (row & 2047)) * 128 + wc * 32 + 8 * fq) * 2u) = w[bj]; }
        } else if (MODE == 2) {
          const unsigned ho = (unsigned)((((row >> 11) * 8 + pn) * 2048 + (row & 2047)) * 128 + wc * 32 + 8 * fq) * 2u;
          *(GLB_AS u32x4*)((GLB_AS char*)uptr(outK) + ho) = w[0]; *(GLB_AS u32x4*)((GLB_AS char*)uptr(outV) + ho) = w[1];
        } else {
          const unsigned oo = (unsigned)(row * ldo + pn * 256 + wc * 32 + 8 * fq) * 2u;
          *(GLB_AS u32x4*)(ob + oo) = w[0]; *(GLB_AS u32x4*)(ob + oo + 256) = w[1];
        }
        asm volatile("" ::: "memory");
      }
  }
};

template <int MODE>
DEV void gemm_phase(char* shm, float* rowsc, const bf16_t* __restrict__ A, int lda, const bf16_t* __restrict__ Bt, int K, int nN, const Epi<MODE>& E,
                    float* halo = nullptr, float* HBp = nullptr, const float* conv_w = nullptr, const float* conv_b = nullptr) {
  constexpr int HALF = 128, HTB = HALF * 64 * 2;
  LDS_AS unsigned char* lds = (LDS_AS unsigned char*)shm;
  const int tid = opaque_tid(), wid = __builtin_amdgcn_readfirstlane(tid >> 6), lane = tid & 63, wr = wid >> 2, wc = wid & 3, fr = lane & 15, fq = lane >> 4;
  const int nt = K / 64;
  Sched S; S.nN = nN; S.nUnits = 32 * nN; S.G = gridDim.x; S.c = blockIdx.x;
  unsigned voffA[2], voffB[2];
#pragma unroll
  for (int i = 0; i < 2; ++i) { int R, C; stage_rc2(tid * 16 + i * 8192, R, C); const int Rb = (R & ~31) + perm32(R & 31);
    const int Ra = MODE == 4 ? ((R & 64) | ((R & 15) << 2) | ((R >> 4) & 3)) : R;
    voffA[i] = (unsigned)(Ra * lda + C) * 2u; voffB[i] = (unsigned)(Rb * K + C) * 2u; }
  const size_t kstep = 128;
  const size_t hstepA = (size_t)HALF * lda * 2, hstepB = (size_t)HALF * K * 2, tstepA = 2 * hstepA, tstepB = 2 * hstepB;
  const unsigned ldsw = (unsigned)wid * 1024u;
  const int aoff = lds_byte2(wr * 64 + fr, fq * 8), boff = lds_byte2(wc * 32 + fr, fq * 8);
  LDS_AS unsigned char* pa = lds + aoff; LDS_AS unsigned char* pb = lds + 4 * HTB + boff;
  asm volatile("" : "+v"(pa), "+v"(pb));
#define PG8_SA(b, h) (((b) * 2 + (h)) * HTB)
#define PG8_SB(b, h) ((4 + (b) * 2 + (h)) * HTB)
#define PG8_STAGE(bufoff, gbase, voff) do { const char* gb_ = uptr(gbase); _Pragma("unroll") for (int _i = 0; _i < 2; ++_i) \
        __builtin_amdgcn_global_load_lds((const unsigned*)(gb_ + (voff)[_i]), (LDS_AS unsigned*)(lds + (bufoff) + ldsw + _i * 8192), 16, 0, 0); } while (0)
#define PG8_LDA(dst, b, h) do { _Pragma("unroll") for (int m = 0; m < 4; ++m) _Pragma("unroll") for (int k = 0; k < 2; ++k) dst[m][k] = *(const LDS_AS bf16x8*)(pa + (PG8_SA(b, h) + m * 2048 + k * 1024)); } while (0)
#define PG8_LDB(dst, b, h) do { _Pragma("unroll") for (int n = 0; n < 2; ++n) _Pragma("unroll") for (int k = 0; k < 2; ++k) dst[n][k] = *(const LDS_AS bf16x8*)(pb + (PG8_SA(b, h) + n * 2048 + k * 1024)); } while (0)
#define PG8_MMA(ai, bj, At, Bt_) do { __builtin_amdgcn_s_setprio(1); _Pragma("unroll") for (int m = 0; m < 4; ++m) _Pragma("unroll") for (int n = 0; n < 2; ++n) _Pragma("unroll") for (int k = 0; k < 2; ++k) \
        acc[ai][bj][m][n] = __builtin_amdgcn_mfma_f32_16x16x32_bf16(Bt_[n][k], At[m][k], acc[ai][bj][m][n], 0, 0, 0); __builtin_amdgcn_s_setprio(0); } while (0)
#define PG8_WAIT_V(n) asm volatile("s_waitcnt vmcnt(" #n ")" ::: "memory")
#define PG8_WAIT_L(n) asm volatile("s_waitcnt lgkmcnt(" #n ")" ::: "memory")
#define PG8_BAR __builtin_amdgcn_s_barrier()
#define PG8_SCHED __builtin_amdgcn_sched_barrier(0)
  Unit cur, nxt; int ui = 0;
  if (!S.next(0, cur)) return;
  f32x4 acc[2][2][4][2];
#pragma unroll
  for (int a = 0; a < 2; ++a)
#pragma unroll
    for (int b = 0; b < 2; ++b)
#pragma unroll
      for (int m = 0; m < 4; ++m)
#pragma unroll
        for (int n = 0; n < 2; ++n) acc[a][b][m][n] = (f32x4){0.f, 0.f, 0.f, 0.f};
  bf16x8 At[4][2], B0[2][2], B1[2][2];
  const char* cA = (const char*)A + (size_t)cur.pm * tstepA; const char* cB = (const char*)Bt + (size_t)cur.pn * tstepB;
  if (MODE == 3) E.prep(rowsc, cur.pm * 256, tid);
  PG8_STAGE(PG8_SB(0, 0), cB, voffB); PG8_STAGE(PG8_SB(0, 1), cB + hstepB, voffB); PG8_STAGE(PG8_SA(0, 0), cA, voffA); PG8_STAGE(PG8_SA(0, 1), cA + hstepA, voffA);
  if (wr == 1) PG8_BAR;
  PG8_WAIT_V(2); PG8_BAR;
  PG8_STAGE(PG8_SB(1, 0), cB + kstep, voffB); PG8_STAGE(PG8_SA(1, 0), cA + kstep, voffA); PG8_STAGE(PG8_SB(1, 1), cB + hstepB + kstep, voffB);
  PG8_WAIT_V(6); PG8_BAR;
  for (;;) {
    const bool has_next = S.next(ui + 1, nxt);
    const char* nA = has_next ? (const char*)A + (size_t)nxt.pm * tstepA : cA; const char* nB = has_next ? (const char*)Bt + (size_t)nxt.pn * tstepB : cB;
    const float* rsc = rowsc + (ui & 1) * 512;
    for (int t = 0; t < nt; t += 2) {
      const bool last = (t == nt - 2);
      const char* a1 = cA + (size_t)(t + 1) * kstep;
      const char* a2 = last ? nA : cA + (size_t)(t + 2) * kstep; const char* b2 = last ? nB : cB + (size_t)(t + 2) * kstep;
      const char* a3 = a2 + kstep; const char* b3 = b2 + kstep;
      if (MODE == 3) { if (t == 16) E.hook(acc, rsc, wr, fr); }
      PG8_LDB(B0, 0, 0); PG8_LDB(B1, 0, 1); PG8_SCHED; PG8_LDA(At, 0, 0); PG8_STAGE(PG8_SA(1, 1), a1 + hstepA, voffA);
      PG8_WAIT_V(8); PG8_WAIT_L(0); PG8_BAR; PG8_MMA(0, 0, At, B0); PG8_MMA(0, 1, At, B1); PG8_BAR; PG8_SCHED;
      PG8_LDA(At, 0, 1); PG8_STAGE(PG8_SB(0, 0), b2, voffB); PG8_STAGE(PG8_SB(0, 1), b2 + hstepB, voffB); PG8_STAGE(PG8_SA(0, 0), a2, voffA);
      PG8_WAIT_V(8); PG8_WAIT_L(0); PG8_BAR; PG8_MMA(1, 0, At, B0); PG8_MMA(1, 1, At, B1); PG8_BAR; PG8_SCHED;
      PG8_LDB(B0, 1, 0); PG8_LDB(B1, 1, 1); PG8_SCHED; PG8_LDA(At, 1, 0); PG8_STAGE(PG8_SA(0, 1), a2 + hstepA, voffA);
      PG8_WAIT_V(8); PG8_WAIT_L(0); PG8_BAR; PG8_MMA(0, 0, At, B0); PG8_MMA(0, 1, At, B1); PG8_BAR; PG8_SCHED;
      PG8_LDA(At, 1, 1); PG8_STAGE(PG8_SB(1, 0), b3, voffB); PG8_STAGE(PG8_SB(1, 1), b3 + hstepB, voffB); PG8_STAGE(PG8_SA(1, 0), a3, voffA);
      PG8_WAIT_V(8); PG8_WAIT_L(0); PG8_BAR; PG8_MMA(1, 0, At, B0); PG8_MMA(1, 1, At, B1); PG8_BAR; PG8_SCHED;
    }
    if (wr == 0) PG8_BAR;
    { const int t2 = opaque_tid();
      if (MODE == 4) epi_up(acc, cur.pm, cur.pn, (t2 >> 8) & 1, (t2 >> 6) & 3, t2 & 15, (t2 >> 4) & 3, halo, E.out, HBp, conv_w, conv_b);
      else E(acc, cur.pm, cur.pn, (t2 >> 8) & 1, (t2 >> 6) & 3, t2 & 15, (t2 >> 4) & 3, rsc); }
    if (!has_next) break;
#pragma unroll
    for (int a = 0; a < 2; ++a)
#pragma unroll
      for (int b = 0; b < 2; ++b)
#pragma unroll
        for (int m = 0; m < 4; ++m)
#pragma unroll
          for (int n = 0; n < 2; ++n) acc[a][b][m][n] = (f32x4){0.f, 0.f, 0.f, 0.f};
    cur = nxt; cA = nA; cB = nB; ++ui;
    if (MODE == 3) E.prep(rowsc + (ui & 1) * 512, cur.pm * 256, tid);
    if (wr == 1) PG8_BAR;
  }
  PG8_WAIT_V(0);
  PG8_BAR;
#undef PG8_SA
#undef PG8_SB
#undef PG8_STAGE
#undef PG8_LDA
#undef PG8_LDB
#undef PG8_MMA
#undef PG8_WAIT_V
#undef PG8_WAIT_L
#undef PG8_BAR
#undef PG8_SCHED
}

DEV int v_st(int k, int c) { const int kk = (k & ~0xC) | ((k & 4) << 1) | ((k & 8) >> 1); return ((kk >> 3) * 4 + (c >> 5)) * 512 + ((kk & 7) * 32 + (c & 31)) * 2; }
DEV int v_rd_base(int lane) { return ((lane & 3) << 3) | (((lane >> 2) & 3) << 6) | (((lane >> 4) & 1) << 5) | (((lane >> 5) & 1) << 8); }
constexpr int v_rd_off(int d0, int ks, int half) { return d0 * 512 + ks * 4096 + half * 2048; }
template <int OFF> DEV s16x4 tr_read(int vb) { s16x4 r; asm volatile("ds_read_b64_tr_b16 %0, %1 offset:%2" : "=&v"(r) : "v"(vb), "i"(OFF) : "memory"); return r; }
template <int D0> DEV void pv_one(f32x16& od, int vb, bf16x8 pa0, bf16x8 pa1, bf16x8 pa2, bf16x8 pa3) {
  const s16x4 l0 = tr_read<v_rd_off(D0, 0, 0)>(vb), h0 = tr_read<v_rd_off(D0, 0, 1)>(vb), l1 = tr_read<v_rd_off(D0, 1, 0)>(vb), h1 = tr_read<v_rd_off(D0, 1, 1)>(vb);
  const s16x4 l2 = tr_read<v_rd_off(D0, 2, 0)>(vb), h2 = tr_read<v_rd_off(D0, 2, 1)>(vb), l3 = tr_read<v_rd_off(D0, 3, 0)>(vb), h3 = tr_read<v_rd_off(D0, 3, 1)>(vb);
  asm volatile("s_waitcnt lgkmcnt(0)" ::: "memory"); SBAR();
#define PKV(L, H) (bf16x8){L[0], L[1], L[2], L[3], H[0], H[1], H[2], H[3]}
  od = __builtin_amdgcn_mfma_f32_32x32x16_bf16(pa0, PKV(l0, h0), od, 0, 0, 0);
  od = __builtin_amdgcn_mfma_f32_32x32x16_bf16(pa1, PKV(l1, h1), od, 0, 0, 0);
  od = __builtin_amdgcn_mfma_f32_32x32x16_bf16(pa2, PKV(l2, h2), od, 0, 0, 0);
  od = __builtin_amdgcn_mfma_f32_32x32x16_bf16(pa3, PKV(l3, h3), od, 0, 0, 0);
#undef PKV
}
#define PK4(P, BASE, OUT) do { unsigned a0_ = cvtpk(P[BASE + 0], P[BASE + 1]), a1_ = cvtpk(P[BASE + 2], P[BASE + 3]);   \
    unsigned b0_ = cvtpk(P[BASE + 4], P[BASE + 5]), b1_ = cvtpk(P[BASE + 6], P[BASE + 7]);                              \
    auto r0_ = __builtin_amdgcn_permlane32_swap(a0_, b0_, false, false); auto r1_ = __builtin_amdgcn_permlane32_swap(a1_, b1_, false, false); \
    u32x4 w_ = {r0_[0], r1_[0], r0_[1], r1_[1]}; OUT = *reinterpret_cast<bf16x8*>(&w_); } while (0)

DEV void sb_half(f32x16& P, float& run, bool diag, int key0, int qrow, int hi) {
  constexpr float C = 0.08838834764831845f * 1.4426950408889634f;
#pragma unroll
  for (int r = 0; r < 16; ++r) P[r] = fmaxf(P[r], -100.f);
  if (diag) {
#pragma unroll
    for (int r = 0; r < 16; ++r) { if (key0 + crow(r, hi) >= qrow) P[r] = -100.f; }
  }
  f32x16 L;
#pragma unroll
  for (int r = 0; r < 16; ++r) { const float em = __builtin_amdgcn_exp2f(-P[r]); const float be = __builtin_amdgcn_rcpf(1.f + em); P[r] = be; L[r] = em * be; }
#pragma unroll
  for (int g = 3; g >= 0; --g) {
    const float gs = (L[4 * g] * L[4 * g + 1]) * (L[4 * g + 2] * L[4 * g + 3]);
    auto rr = __builtin_amdgcn_permlane32_swap(__float_as_uint(gs), __float_as_uint(gs), false, false);
    const float lo = __uint_as_float(rr[0]), hv = __uint_as_float(rr[1]);
    const float e3 = run * (hi == 0 ? hv : 1.f), e2 = e3 * L[4 * g + 3], e1 = e2 * L[4 * g + 2], e0 = e1 * L[4 * g + 1];
    run *= lo * hv;
    P[4 * g + 3] *= e3; P[4 * g + 2] *= e2; P[4 * g + 1] *= e1; P[4 * g + 0] *= e0;
  }
}
DEV void sb_tile(f32x16& p0, f32x16& p1, float& carry, bool diag, int kt0, int qrow, int hi) {
  sb_half(p1, carry, diag, kt0 + 32, qrow, hi);
  sb_half(p0, carry, diag, kt0, qrow, hi);
}

template <bool MLA>
DEV void attn_unit(char* lds, const bf16_t* __restrict__ Qb, int ldq, const bf16_t* __restrict__ Kb, int ldk, const bf16_t* __restrict__ Krb, int ldkr,
                   const bf16_t* __restrict__ Vb, int ldv, bf16_t* __restrict__ Ob, int ldo, float* __restrict__ statb, int qb, const float* __restrict__ cosb, const float* __restrict__ sinb) {
  constexpr int DQ = MLA ? 192 : 128, ND = DQ / 16, ROWB = DQ * 2, SHMK = 64 * ROWB, SHMV = 16384, VOFF = 2 * SHMK, SCR = VOFF + 3 * SHMV;
#define KSWZ(row, colB) ((row) * ROWB + ((colB) ^ (((row) & 7) << 4)))
  const int tid = opaque_tid(), wid = tid >> 6, lane = tid & 63, r32 = lane & 31, hi = lane >> 5;
  float* al_l = (float*)(lds + SCR + wid * 256); float* li_l = al_l + 32;
  char* qlds = lds + SCR + 2048 + wid * 4096 + lane * 16;
  const int q0w = 256 * qb + 32 * wid, qrow = q0w + r32;
  bf16x8 qr[ND];
  { const bf16_t* Qw = Qb + (size_t)qrow * ldq + hi * 8;
#pragma unroll
    for (int d0 = 0; d0 < ND; ++d0) qr[d0] = *(const bf16x8*)(Qw + d0 * 16); }
  if (MLA) {
#pragma unroll
    for (int dd = 0; dd < 2; ++dd) {
      const float* cp = cosb + (size_t)qrow * 32 + dd * 16 + hi * 8; const float* sp = sinb + (size_t)qrow * 32 + dd * 16 + hi * 8;
      const f32x4 c0 = *(const f32x4*)cp, c1 = *(const f32x4*)(cp + 4), s0 = *(const f32x4*)sp, s1 = *(const f32x4*)(sp + 4);
      const u32x4 a = __builtin_bit_cast(u32x4, qr[ND - 4 + dd]), b = __builtin_bit_cast(u32x4, qr[ND - 2 + dd]);
      u32x4 ya, yb;
#pragma unroll
      for (int q = 0; q < 4; ++q) {
        const float cl = q < 2 ? c0[2 * q] : c1[2 * q - 4], ch = q < 2 ? c0[2 * q + 1] : c1[2 * q - 3];
        const float sl = q < 2 ? s0[2 * q] : s1[2 * q - 4], sh = q < 2 ? s0[2 * q + 1] : s1[2 * q - 3];
        const float x1l = bf_lo(a[q]), x1h = bf_hi(a[q]), x2l = bf_lo(b[q]), x2h = bf_hi(b[q]);
        ya[q] = cvtpk(x1l * cl - x2l * sl, x1h * ch - x2h * sh); yb[q] = cvtpk(x1l * sl + x2l * cl, x1h * sh + x2h * ch);
      }
      qr[ND - 4 + dd] = __builtin_bit_cast(bf16x8, ya); qr[ND - 2 + dd] = __builtin_bit_cast(bf16x8, yb);
    }
#pragma unroll
    for (int d = 0; d < 4; ++d) *(bf16x8*)(qlds + d * 1024) = qr[ND - 4 + d];
  }
  f32x16 o[4];
#pragma unroll
  for (int d = 0; d < 4; ++d)
#pragma unroll
    for (int r = 0; r < 16; ++r) o[d][r] = 0.f;
  float carry = 1.f, m_reg = -1e30f, l_reg = 0.f;
  const int NT = 4 * qb + 4, jmax = 4 * qb + (wid >> 1);
  const int sr = tid >> 4, sc = (tid & 15) * 8, vst0 = v_st(sr, sc), vst1 = v_st(32 + sr, sc), krr = tid >> 3, krc = (tid & 7) * 8;
  const int vb0 = (int)(unsigned)(uintptr_t)(lds + VOFF) + v_rd_base(lane);
  bf16x8 ks0, ks1, vs0, vs1, kx;
#define A_LOAD(jt) do { const int kt0_ = (jt) * 64; \
    ks0 = *(const bf16x8*)(Kb + (size_t)(kt0_ + sr) * ldk + sc); ks1 = *(const bf16x8*)(Kb + (size_t)(kt0_ + 32 + sr) * ldk + sc); \
    vs0 = *(const bf16x8*)(Vb + (size_t)(kt0_ + sr) * ldv + sc); vs1 = *(const bf16x8*)(Vb + (size_t)(kt0_ + 32 + sr) * ldv + sc); \
    if (MLA) kx = *(const bf16x8*)(Krb + (size_t)(kt0_ + krr) * ldkr + krc); SBAR(); } while (0)
#define A_WRITE(kb, vslot) do { char* base_ = lds + (kb) * SHMK; char* vbase_ = lds + VOFF + (vslot) * SHMV; \
    *(bf16x8*)(base_ + KSWZ(sr, sc * 2)) = ks0; *(bf16x8*)(base_ + KSWZ(32 + sr, sc * 2)) = ks1; \
    *(bf16x8*)(vbase_ + vst0) = vs0; *(bf16x8*)(vbase_ + vst1) = vs1; \
    if (MLA) *(bf16x8*)(base_ + KSWZ(krr, (128 + krc) * 2)) = kx; } while (0)
#define A_PV(vslot) do { const int vb_ = vb0 + (vslot) * SHMV; \
    pv_one<0>(o[0], vb_, pa0, pa1, pa2, pa3); pv_one<1>(o[1], vb_, pa0, pa1, pa2, pa3); pv_one<2>(o[2], vb_, pa0, pa1, pa2, pa3); pv_one<3>(o[3], vb_, pa0, pa1, pa2, pa3); } while (0)
  const bool late = wid >= 4; bool pend = false;
  bool done_w = false; int* dflag = (int*)(lds + SCR + 2048);
  bf16x8 pa0, pa1, pa2, pa3;
  A_LOAD(NT - 1); A_WRITE(0, 0); A_LOAD(NT - 2); __syncthreads();
  int vs = 0;
  for (int i = 0; i < NT; ++i) {
    const int jt = NT - 1 - i, cur = i & 1, vnext = vs == 2 ? 0 : vs + 1, vprev = vs == 0 ? 2 : vs - 1;
    if (i + 1 < NT) A_WRITE(cur ^ 1, vnext);
    if (late && pend) { A_PV(vprev); pend = false; }
    if (jt > jmax || done_w) { if (i + 2 < NT) A_LOAD(jt - 2); }
    else {
      const char* Kl = lds + cur * SHMK;
      f32x16 p0, p1;
#pragma unroll
      for (int r = 0; r < 16; ++r) { p0[r] = 0.f; p1[r] = 0.f; }
      {
        bf16x8 kb0[4], kb1[4], qb0[2], qb1[2];
#define QK_LOAD(KB, QB, bt) do { _Pragma("unroll") for (int u_ = 0; u_ < 2; ++u_) { const int d0_ = 2 * (bt) + u_; const int cb_ = (d0_ * 16 + hi * 8) * 2; \
          KB[2 * u_] = *(const bf16x8*)(Kl + KSWZ(r32, cb_)); KB[2 * u_ + 1] = *(const bf16x8*)(Kl + KSWZ(32 + r32, cb_)); \
          if (MLA && d0_ >= 8) QB[u_] = *(const bf16x8*)(qlds + (d0_ - 8) * 1024); else QB[u_] = qr[d0_ < 8 ? d0_ : 0]; } } while (0)
#define QK_MMA(KB, QB) do { _Pragma("unroll") for (int u_ = 0; u_ < 2; ++u_) { \
          p0 = __builtin_amdgcn_mfma_f32_32x32x16_bf16(KB[2 * u_], QB[u_], p0, 0, 0, 0); p1 = __builtin_amdgcn_mfma_f32_32x32x16_bf16(KB[2 * u_ + 1], QB[u_], p1, 0, 0, 0); } } while (0)
        QK_LOAD(kb0, qb0, 0); SBAR();
#pragma unroll
        for (int bt = 0; bt < ND / 2; bt += 2) {
          QK_LOAD(kb1, qb1, bt + 1); SBAR();
          QK_MMA(kb0, qb0); SBAR();
          if (bt + 2 < ND / 2) { QK_LOAD(kb0, qb0, bt + 2); SBAR(); }
          QK_MMA(kb1, qb1); SBAR();
        }
#undef QK_LOAD
#undef QK_MMA
      }
      if (MLA) {
        constexpr float C2 = 0.07216878364870323f * 1.4426950408889634f;
        float pmax = p0[0];
#pragma unroll
        for (int r = 1; r < 16; ++r) pmax = fmaxf(pmax, p0[r]);
#pragma unroll
        for (int r = 0; r < 16; ++r) pmax = fmaxf(pmax, p1[r]);
        { auto rr = __builtin_amdgcn_permlane32_swap(__float_as_uint(pmax), __float_as_uint(pmax), false, false);
          pmax = fmaxf(__uint_as_float(rr[0]), __uint_as_float(rr[1])); }
        float mn, alpha;
        if (__all(pmax - m_reg <= 8.f / 0.07216878364870323f)) { mn = m_reg; alpha = 1.f; }
        else { mn = fmaxf(m_reg, pmax); alpha = __builtin_amdgcn_exp2f((m_reg - mn) * C2); m_reg = mn; }
        const float mnC = -mn * C2;
        float ps = 0.f;
#pragma unroll
        for (int r = 0; r < 16; ++r) { p0[r] = __builtin_amdgcn_exp2f(fmaf(p0[r], C2, mnC)); p1[r] = __builtin_amdgcn_exp2f(fmaf(p1[r], C2, mnC)); ps += p0[r] + p1[r]; }
        { auto rr = __builtin_amdgcn_permlane32_swap(__float_as_uint(ps), __float_as_uint(ps), false, false);
          ps = __uint_as_float(rr[0]) + __uint_as_float(rr[1]); }
        l_reg = l_reg * alpha + ps;
        if (__any(alpha < 1.f)) {
          if (hi == 0) al_l[r32] = alpha;
          asm volatile("s_waitcnt lgkmcnt(0)" ::: "memory");
#pragma unroll
          for (int r = 0; r < 16; ++r) { const float a = al_l[crow(r, hi)];
#pragma unroll
            for (int d = 0; d < 4; ++d) o[d][r] *= a; }
        }
      } else {
        sb_tile(p0, p1, carry, jt == jmax, jt * 64, qrow, hi);
        done_w = __all(carry < 1e-18f);
      }
      PK4(p0, 0, pa0); PK4(p0, 8, pa1); PK4(p1, 0, pa2); PK4(p1, 8, pa3);
      if (i + 2 < NT) A_LOAD(jt - 2);
      if (late) pend = true; else A_PV(vs);
    }
    if (!MLA) { if (lane == 0) dflag[(i & 1) * 8 + wid] = done_w ? 1 : 0; }
    __syncthreads();
    vs = vnext;
    if (!MLA) {
      const int* df = dflag + (i & 1) * 8;
      if ((df[0] & df[1] & df[2] & df[3] & df[4] & df[5] & df[6] & df[7]) != 0) break;
    }
  }
  if (late && pend) { const int vlast = vs == 0 ? 2 : vs - 1; A_PV(vlast); }
  __syncthreads();
  if (MLA) {
    if (hi == 0) li_l[r32] = l_reg;
    asm volatile("s_waitcnt lgkmcnt(0)" ::: "memory");
#pragma unroll
    for (int r = 0; r < 16; ++r) { const float rl = __builtin_amdgcn_rcpf(li_l[crow(r, hi)]);
#pragma unroll
      for (int d = 0; d < 4; ++d) o[d][r] *= rl; }
  }
#pragma unroll
  for (int r = 0; r < 16; ++r) {
    const int orow = q0w + crow(r, hi);
    float s = (o[0][r] * o[0][r] + o[1][r] * o[1][r]) + (o[2][r] * o[2][r] + o[3][r] * o[3][r]);
    s += __shfl_xor(s, 16); s += __shfl_xor(s, 8); s += __shfl_xor(s, 4); s += __shfl_xor(s, 2); s += __shfl_xor(s, 1);
    if (r32 == 0) statb[(size_t)orow * 16] = s;
#pragma unroll
    for (int d = 0; d < 4; ++d) Ob[(size_t)orow * ldo + d * 32 + r32] = (bf16_t)(cvtpk(o[d][r], o[d][r]) & 0xffffu);
  }
#undef A_LOAD
#undef A_WRITE
#undef A_PV
#undef KSWZ
}

struct TrTile { const float* src; bf16_t* dst; const float* g; int K, N, k0, n0, perm; };
DEV TrTile tr_decode(const Params& p, char* ws, int ti) {
  TrTile t; t.g = nullptr; t.perm = 0; int ntn, loc;
  if (ti < 512) { t.src = p.w_in; t.dst = (bf16_t*)(ws + OFF_WIN); t.K = 2048; t.N = INC; ntn = 16; loc = ti; }
  else if (ti < 560) { t.src = p.w_uq; t.dst = (bf16_t*)(ws + OFF_WUQ); t.g = p.g_cq; t.K = 512; t.N = 1536; ntn = 6; loc = ti - 512; }
  else if (ti < 592) { t.src = p.w_ukv; t.dst = (bf16_t*)(ws + OFF_WUKV); t.g = p.g_ckv; t.K = 256; t.N = 2048; ntn = 8; loc = ti - 560; }
  else if (ti < 848) { t.src = p.w_o; t.dst = (bf16_t*)(ws + OFF_WO); t.K = 2048; t.N = 2048; ntn = 8; loc = ti - 592; }
  else if (ti < 2256) { t.src = p.w_up; t.dst = (bf16_t*)(ws + OFF_WUP); t.K = 2048; t.N = DFF2; ntn = 44; loc = ti - 848; t.perm = 1; }
  else { t.src = p.w_down; t.dst = (bf16_t*)(ws + OFF_WDN); t.K = DFF; t.N = 2048; ntn = 8; loc = ti - 2256; }
  const int kt = loc / ntn; t.k0 = kt * 64; t.n0 = (loc % ntn) * 256;
  if (ti >= 592 && ti < 848) t.g = (kt < 16) ? p.g_out_sb : (p.g_out_mla - 1024);
  return t;
}
DEV void tr_load(const TrTile& t, f32x4 (&v)[8], int tid) {
  const int n4 = (tid & 63) * 4, kr = tid >> 6;
#pragma unroll
  for (int i = 0; i < 8; ++i) {
    const int k = kr + 8 * i; v[i] = (f32x4){0.f, 0.f, 0.f, 0.f};
    if (t.n0 + n4 < t.N) v[i] = __builtin_nontemporal_load((const f32x4*)(t.src + (size_t)(t.k0 + k) * t.N + t.n0 + n4));
  }
}
DEV void tr_to_lds(const TrTile& t, const f32x4 (&v)[8], float* tile, int tid) {
  const int n4 = (tid & 63) * 4, kr = tid >> 6;
#pragma unroll
  for (int i = 0; i < 8; ++i) { const int k = kr + 8 * i; f32x4 x = v[i]; if (t.g) x *= t.g[t.k0 + k]; *(f32x4*)(tile + k * 260 + n4) = x; }
}
DEV void tr_store(const TrTile& t, const float* tile, int tid) {
  const int n = tid >> 1, kh = (tid & 1) * 32;
#pragma unroll
  for (int q = 0; q < 4; ++q) {
    u32x4 w;
#pragma unroll
    for (int j = 0; j < 4; ++j) w[j] = cvtpk(tile[(kh + 8 * q + 2 * j) * 260 + n], tile[(kh + 8 * q + 2 * j + 1) * 260 + n]);
    int dn = t.n0 + n;
    if (t.perm) { const int bj = dn >= DFF ? 1 : 0, ch = dn - bj * DFF; dn = (ch >> 7) * 256 + bj * 128 + (ch & 127); }
    *(u32x4*)(t.dst + (size_t)dn * t.K + t.k0 + kh + 8 * q) = w;
  }
}


DEV unsigned long long probe_begin(int k) { return (k == AMP_PHASE) ? __builtin_amdgcn_s_memrealtime() : 0ull; }
DEV void probe_end(int k, unsigned long long t0, const XcdBarrier& xb) {
  if (k == AMP_PHASE) {
    if (blockIdx.x == 0 && threadIdx.x == 0) { const unsigned long long t1 = __builtin_amdgcn_s_memrealtime(); while (__builtin_amdgcn_s_memrealtime() - t1 < (t1 - t0)) __builtin_amdgcn_s_sleep(4); }
    xcd_barrier(xb);
  }
}
__global__ void __launch_bounds__(512, 2) fwd_kernel(Params p) {
  __shared__ __attribute__((aligned(1024))) char shm[135168];
  __shared__ int s_unit;
  __shared__ float rowsc[1024];
  __shared__ __attribute__((aligned(16))) float halo[2048];
  __shared__ uint4 xb_words;
  cg::grid_group grid = cg::this_grid();
  if (threadIdx.x == 0) xb_words = make_uint4(0u, 0u, 0u, 0u);
  __syncthreads();
  unsigned* BAR = (unsigned*)(p.ws + OFF_CNT);
  const XcdBarrier xb = xcd_barrier_post(BAR, (volatile LDS_AS unsigned*)&xb_words);
  if (p.ws == nullptr) grid.sync();
  const int bid = blockIdx.x, nblk = gridDim.x;
  char* ws = p.ws;
  bf16_t* WIN = (bf16_t*)(ws + OFF_WIN); bf16_t* WUQ = (bf16_t*)(ws + OFF_WUQ); bf16_t* WUKV = (bf16_t*)(ws + OFF_WUKV); bf16_t* WO = (bf16_t*)(ws + OFF_WO);
  bf16_t* H = (bf16_t*)(ws + OFF_H); bf16_t* Y = (bf16_t*)(ws + OFF_Y); bf16_t* ACT = (bf16_t*)(ws + OFF_ACT); bf16_t* WUP = (bf16_t*)(ws + OFF_WUP);
  bf16_t* WDN = (bf16_t*)(ws + OFF_WDN); bf16_t* PROJ = (bf16_t*)(ws + OFF_PROJ); bf16_t* Q = (bf16_t*)(ws + OFF_Q);
  bf16_t* KV = (bf16_t*)(ws + OFF_KV); bf16_t* O = (bf16_t*)(ws + OFF_O); bf16_t* Y2 = (bf16_t*)(ws + OFF_Y2);
  float* COS = (float*)(ws + OFF_COS); float* SIN = (float*)(ws + OFF_SIN); float* STC = (float*)(ws + OFF_STC); float* STO = (float*)(ws + OFF_STO);
  float* STY = (float*)(ws + OFF_STY); float* STY2 = (float*)(ws + OFF_STY2); bf16_t* KR = (bf16_t*)(ws + OFF_KR); bf16_t* KSB = (bf16_t*)(ws + OFF_Y); bf16_t* VSB = KSB + (size_t)T_ * 1024; bf16_t* KM = KV; bf16_t* VM = KV + (size_t)T_ * 1024; float* HB = (float*)(ws + OFF_HB); unsigned* CNT = BAR + XB_QCNT;

  const unsigned long long pt0_ = probe_begin(0);
  PH(0) {
    const int tid = opaque_tid(), wid = tid >> 6, lane = tid & 63;
    {
      float* tile = (float*)shm;
      f32x4 v[8]; TrTile tt;
      int ti = bid;
      if (ti < 848) { tt = tr_decode(p, ws, ti); tr_load(tt, v, tid); }
    {
      const int tb = bid * 8 + wid;
      f32x4 xv[4][8]; float ss[4] = {0.f, 0.f, 0.f, 0.f};
#pragma unroll
      for (int q = 0; q < 4; ++q)
#pragma unroll
        for (int j = 0; j < 8; ++j) { xv[q][j] = __builtin_nontemporal_load((const f32x4*)(p.x + (size_t)(tb + q * 2048) * DM + j * 256 + lane * 4));
          ss[q] += (xv[q][j][0] * xv[q][j][0] + xv[q][j][1] * xv[q][j][1]) + (xv[q][j][2] * xv[q][j][2] + xv[q][j][3] * xv[q][j][3]); }
      float r[4];
#pragma unroll
      for (int q = 0; q < 4; ++q) r[q] = rsqrtf(wave_sum(ss[q]) * (1.f / 2048.f) + EPS);
#pragma unroll
      for (int j = 0; j < 8; ++j) { const f32x4 g4 = *(const f32x4*)(p.g_attn_pre + j * 256 + lane * 4);
#pragma unroll
        for (int q = 0; q < 4; ++q) { const f32x4 y = xv[q][j] * r[q] * g4;
          u32x2 w; w[0] = cvtpk(y[0], y[1]); w[1] = cvtpk(y[2], y[3]); *(u32x2*)(H + (size_t)(tb + q * 2048) * DM + j * 256 + lane * 4) = w; } }
    }
      for (; ti < 848; ti += nblk) {
        tr_to_lds(tt, v, tile, tid);
        __syncthreads();
        const TrTile cur = tt;
        if (ti + nblk < 848) { tt = tr_decode(p, ws, ti + nblk); tr_load(tt, v, tid); }
        tr_store(cur, tile, tid);
        __syncthreads();
      }
    }
    for (int idx = bid * 512 + tid; idx < T_ * 32; idx += nblk * 512) {
      const int t = idx >> 5, fi = idx & 31;
      const float inv = exp2f(-(float)fi * (13.287712379549449f / 32.f));
      const float ang = (float)p.pos[t] * inv;
      double rev = (double)ang * 0.15915494309189535; rev -= floor(rev);
      const float rf = (float)rev;
      COS[idx] = __builtin_amdgcn_cosf(rf); SIN[idx] = __builtin_amdgcn_sinf(rf);
    }
  }
  xcd_barrier(xb);
  probe_end(0, pt0_, xb);
  for (int es_ = 0; es_ < EXTRA_SYNC; ++es_) xcd_barrier(xb);
  const unsigned long long pt1_ = probe_begin(1);
  PH(1) { Epi<0> e; e.outK = KSB; e.outV = VSB; e.out = PROJ; e.ldo = INP; e.st_in = nullptr; e.st_out = STC;
    gemm_phase<0>(shm, rowsc, H, DM, WIN, 2048, 16, e); }
  xcd_barrier(xb);
  probe_end(1, pt1_, xb);
  const unsigned long long pt2_ = probe_begin(2);
  PH(2) {
    for (int idx = bid * 512 + opaque_tid(); idx < T_ * 32; idx += nblk * 512) {
      const int t = idx >> 5, i = idx & 31;
      const float x1 = __uint_as_float((unsigned)PROJ[(size_t)t * INP + 3840 + i] << 16), x2 = __uint_as_float((unsigned)PROJ[(size_t)t * INP + 3872 + i] << 16);
      const float c = COS[idx], sn = SIN[idx];
      KR[(size_t)t * 64 + i] = (bf16_t)(cvtpk(x1 * c - x2 * sn, 0.f) & 0xffffu); KR[(size_t)t * 64 + 32 + i] = (bf16_t)(cvtpk(x1 * sn + x2 * c, 0.f) & 0xffffu);
    }
    Epi<1> e; e.out = Q; e.ldo = 1536; e.st_in = STC; e.st_out = nullptr;
    gemm_phase<1>(shm, rowsc, PROJ + 3072, INP, WUQ, 512, 6, e);
    Epi<2> e2; e2.outK = KM; e2.outV = VM; e2.out = KV; e2.ldo = 2048; e2.st_in = STC; e2.st_out = nullptr;
    gemm_phase<2>(shm, rowsc, PROJ + 3584, INP, WUKV, 256, 8, e2); }
  xcd_barrier(xb);
  probe_end(2, pt2_, xb);
  const unsigned long long pt3_ = probe_begin(3);
  PH(3) for (int first_ = 1;; first_ = 0) {
    const int tid = opaque_tid();
    int u;
    if (first_) u = bid;
    else {
      if (tid == 0) s_unit = 256 + (int)atomicAdd(CNT, 1u);
      __syncthreads();
      u = s_unit;
      __syncthreads();
    }
    if (u >= 512 + 352) break;
    if (u >= 512) {
      float* tile = (float*)shm; f32x4 v[8]; TrTile tt;
      int ti = 848 + 4 * (u - 512); const int te = ti + 4;
      tt = tr_decode(p, ws, ti); tr_load(tt, v, tid);
      for (; ti < te; ++ti) {
        tr_to_lds(tt, v, tile, tid);
        __syncthreads();
        const TrTile cur = tt;
        if (ti + 1 < te) { tt = tr_decode(p, ws, ti + 1); tr_load(tt, v, tid); }
        tr_store(cur, tile, tid);
        __syncthreads();
      }
      continue;
    }
    const int mla = u < 256 ? 1 : 0, v_ = u & 255, qb = 7 - (v_ >> 5), b = (v_ & 31) >> 3, h = v_ & 7;
    const size_t r0 = (size_t)b * SEQ;
    if (mla) attn_unit<true>(shm, Q + r0 * 1536 + h * 192, 1536, KM + ((size_t)(b * 8 + h) * 2048) * 128, 128, KR + r0 * 64, 64, VM + ((size_t)(b * 8 + h) * 2048) * 128, 128,
                             O + r0 * 2048 + 1024 + h * 128, 2048, STO + r0 * 16 + 8 + h, qb, COS + r0 * 32, SIN + r0 * 32);
    else attn_unit<false>(shm, PROJ + r0 * INP + h * 128, INP, KSB + ((size_t)(b * 8 + h) * 2048) * 128, 128, nullptr, 0, VSB + ((size_t)(b * 8 + h) * 2048) * 128, 128,
                          O + r0 * 2048 + h * 128, 2048, STO + r0 * 16 + h, qb, nullptr, nullptr);
  }
  xcd_barrier(xb);
  probe_end(3, pt3_, xb);
  const unsigned long long pt4_ = probe_begin(4);
  PH(4) { Epi<3> e; e.out = Y; e.ldo = 2048; e.st_in = STO; e.st_out = STY;
    gemm_phase<3>(shm, rowsc, O, 2048, WO, 2048, 8, e); }
  xcd_barrier(xb);
  probe_end(4, pt4_, xb);
  const unsigned long long pt5_ = probe_begin(5);
  PH(5) for (int i = 0; i < 4; i += 2) {
    const int tid = opaque_tid(), wid = tid >> 6, lane = tid & 63;
    const int tb = bid * 8 + wid + i * 2048;
    float r[2]; f32x4 x1[2][4][2]; float ss[2];
#pragma unroll
    for (int q = 0; q < 2; ++q) {
      float s = STY[(size_t)(tb + q * 2048) * 32 + (lane & 31)];
      s += __shfl_xor(s, 16); s += __shfl_xor(s, 8); s += __shfl_xor(s, 4); s += __shfl_xor(s, 2); s += __shfl_xor(s, 1);
      r[q] = rsqrtf(s * (1.f / 2048.f) + EPS); ss[q] = 0.f;
    }
#pragma unroll
    for (int j = 0; j < 4; ++j) {
      const int c = j * 512 + lane * 8;
      const f32x4 ga = *(const f32x4*)(p.g_attn_post + c), gb = *(const f32x4*)(p.g_attn_post + c + 4);
#pragma unroll
      for (int q = 0; q < 2; ++q) {
        const size_t ro = (size_t)(tb + q * 2048) * DM + c;
        const u32x4 yw = *(const u32x4*)(Y + ro);
        const f32x4 xa = __builtin_nontemporal_load((const f32x4*)(p.x + ro)), xb2 = __builtin_nontemporal_load((const f32x4*)(p.x + ro + 4));
        const f32x4 ya = {bf_lo(yw[0]), bf_hi(yw[0]), bf_lo(yw[1]), bf_hi(yw[1])}, yb = {bf_lo(yw[2]), bf_hi(yw[2]), bf_lo(yw[3]), bf_hi(yw[3])};
        x1[q][j][0] = xa + ya * r[q] * ga; x1[q][j][1] = xb2 + yb * r[q] * gb;
        { u32x4 xw; xw[0] = cvtpk(x1[q][j][0][0], x1[q][j][0][1]); xw[1] = cvtpk(x1[q][j][0][2], x1[q][j][0][3]); xw[2] = cvtpk(x1[q][j][1][0], x1[q][j][1][1]); xw[3] = cvtpk(x1[q][j][1][2], x1[q][j][1][3]);
          *(u32x4*)(Y + ro) = xw; }
#pragma unroll
        for (int h = 0; h < 2; ++h) ss[q] += (x1[q][j][h][0] * x1[q][j][h][0] + x1[q][j][h][1] * x1[q][j][h][1]) + (x1[q][j][h][2] * x1[q][j][h][2] + x1[q][j][h][3] * x1[q][j][h][3]);
      }
    }
    float r2[2];
#pragma unroll
    for (int q = 0; q < 2; ++q) r2[q] = rsqrtf(wave_sum(ss[q]) * (1.f / 2048.f) + EPS);
#pragma unroll
    for (int j = 0; j < 4; ++j) {
      const int c = j * 512 + lane * 8;
      const f32x4 ga = *(const f32x4*)(p.g_ffn_pre + c), gb = *(const f32x4*)(p.g_ffn_pre + c + 4);
#pragma unroll
      for (int q = 0; q < 2; ++q) {
        const f32x4 ha = x1[q][j][0] * r2[q] * ga, hb = x1[q][j][1] * r2[q] * gb;
        u32x4 w; w[0] = cvtpk(ha[0], ha[1]); w[1] = cvtpk(ha[2], ha[3]); w[2] = cvtpk(hb[0], hb[1]); w[3] = cvtpk(hb[2], hb[3]);
        *(u32x4*)(H + (size_t)(tb + q * 2048) * DM + c) = w;
      }
    }
  }
  xcd_barrier(xb);
  probe_end(5, pt5_, xb);
  const unsigned long long pt6_ = probe_begin(6);
  PH(6) { Epi<4> e; e.out = ACT; e.ldo = DFF; e.st_in = nullptr; e.st_out = nullptr;
    gemm_phase<4>(shm, rowsc, H, DM, WUP, 2048, 44, e, halo, HB, p.conv_w, p.conv_b);
    if (bid >= 128) {
      const int tid = opaque_tid(); float* tile = (float*)shm; f32x4 v[8]; TrTile tt;
      int ti = 2256 + (bid - 128);
      if (ti < 2960) { tt = tr_decode(p, ws, ti); tr_load(tt, v, tid); }
      for (; ti < 2960; ti += 128) {
        tr_to_lds(tt, v, tile, tid);
        __syncthreads();
        const TrTile cur = tt;
        if (ti + 128 < 2960) { tt = tr_decode(p, ws, ti + 128); tr_load(tt, v, tid); }
        tr_store(cur, tile, tid);
        __syncthreads();
      }
    } }
  xcd_barrier(xb);
  probe_end(6, pt6_, xb);
  const unsigned long long pt7_ = probe_begin(7);
  PH(7) for (int it = bid * 512 + opaque_tid(); it < 28 * 2 * 1408; it += nblk * 512) {
    const int c4 = it % 1408, rs = (it / 1408) & 1, pmi = it / 2816, pm = (pmi / 7) * 8 + (pmi % 7) + 1, ch = c4 * 4;
    const int colg = (ch >> 7) * 256 + (ch & 127), colv = colg + 128;
    const float* h0 = HB + (size_t)((pm - 1) * 4) * DFF2; const float* h1 = HB + (size_t)(pm * 4) * DFF2;
    const f32x4 gm2 = *(const f32x4*)(h0 + colg), gm1 = *(const f32x4*)(h0 + DFF2 + colg), g0 = *(const f32x4*)(h1 + 2 * DFF2 + colg), g1 = *(const f32x4*)(h1 + 3 * DFF2 + colg);
    const f32x4 vm2 = *(const f32x4*)(h0 + colv), vm1 = *(const f32x4*)(h0 + DFF2 + colv), v0 = *(const f32x4*)(h1 + 2 * DFF2 + colv), v1 = *(const f32x4*)(h1 + 3 * DFF2 + colv);
    const f32x4 cg = rs ? g1 : g0, pg1 = rs ? g0 : gm1, pg2 = rs ? gm1 : gm2, cv = rs ? v1 : v0, pv1 = rs ? v0 : vm1, pv2 = rs ? vm1 : vm2;
    const f32x4 wg0 = *(const f32x4*)(p.conv_w + ch), wg1 = *(const f32x4*)(p.conv_w + DFF2 + ch), wg2 = *(const f32x4*)(p.conv_w + 2 * DFF2 + ch), bg = *(const f32x4*)(p.conv_b + ch);
    const f32x4 wv0 = *(const f32x4*)(p.conv_w + DFF + ch), wv1 = *(const f32x4*)(p.conv_w + DFF2 + DFF + ch), wv2 = *(const f32x4*)(p.conv_w + 2 * DFF2 + DFF + ch), bv = *(const f32x4*)(p.conv_b + DFF + ch);
    const f32x4 ug = wg2 * cg + wg1 * pg1 + wg0 * pg2 + bg, uv = wv2 * cv + wv1 * pv1 + wv0 * pv2 + bv;
    u32x2 w; w[0] = cvtpk(gelu_tanh(ug[0]) * uv[0], gelu_tanh(ug[1]) * uv[1]); w[1] = cvtpk(gelu_tanh(ug[2]) * uv[2], gelu_tanh(ug[3]) * uv[3]);
    *(u32x2*)(ACT + (size_t)(pm * 256 + rs) * DFF + ch) = w;
  }
  xcd_barrier(xb);
  probe_end(7, pt7_, xb);
  const unsigned long long pt8_ = probe_begin(8);
  PH(8) { Epi<5> e; e.out = Y2; e.ldo = 2048; e.st_in = nullptr; e.st_out = STY2;
    gemm_phase<5>(shm, rowsc, ACT, DFF, WDN, DFF, 8, e); }
  xcd_barrier(xb);
  probe_end(8, pt8_, xb);
  const unsigned long long pt9_ = probe_begin(9);
  PH(9) {
    const int tid = opaque_tid(), wid = tid >> 6, lane = tid & 63;
    const int tb = bid * 8 + wid;
    float r[4];
#pragma unroll
    for (int q = 0; q < 4; ++q) {
      float s = STY2[(size_t)(tb + q * 2048) * 32 + (lane & 31)];
      s += __shfl_xor(s, 16); s += __shfl_xor(s, 8); s += __shfl_xor(s, 4); s += __shfl_xor(s, 2); s += __shfl_xor(s, 1);
      r[q] = rsqrtf(s * (1.f / 2048.f) + EPS);
    }
#pragma unroll
    for (int j = 0; j < 4; ++j) {
      const int c = j * 512 + lane * 8;
      const f32x4 ga = *(const f32x4*)(p.g_ffn_post + c), gb = *(const f32x4*)(p.g_ffn_post + c + 4);
#pragma unroll
      for (int q = 0; q < 4; ++q) {
        const size_t ro = (size_t)(tb + q * 2048) * DM + c;
        const u32x4 yw = *(const u32x4*)(Y2 + ro);
        const u32x4 xw = *(const u32x4*)(Y + ro);
        const f32x4 xa = {bf_lo(xw[0]), bf_hi(xw[0]), bf_lo(xw[1]), bf_hi(xw[1])}, xb2 = {bf_lo(xw[2]), bf_hi(xw[2]), bf_lo(xw[3]), bf_hi(xw[3])};
        const f32x4 ya = {bf_lo(yw[0]), bf_hi(yw[0]), bf_lo(yw[1]), bf_hi(yw[1])}, yb = {bf_lo(yw[2]), bf_hi(yw[2]), bf_lo(yw[3]), bf_hi(yw[3])};
        __builtin_nontemporal_store(xa + ya * r[q] * ga, (f32x4*)(p.out + ro)); __builtin_nontemporal_store(xb2 + yb * r[q] * gb, (f32x4*)(p.out + ro + 4));
      }
    }
  }
}

extern "C" void kernel_launch(void* const* d_in, const int* in_sizes, int n_in, void* d_out, int out_size, void* d_ws, size_t ws_size, hipStream_t stream) {
  if (n_in != 18 || ws_size < WS_END) { fprintf(stderr, "kernel_launch: unexpected n_in %d / ws_size %zu (need %zu)\n", n_in, ws_size, (size_t)WS_END); return; }
  static int grid_blocks = 0;
  if (!grid_blocks) {
    int dev = 0, cus = 0, per_cu = 0;
    (void)hipGetDevice(&dev);
    (void)hipDeviceGetAttribute(&cus, hipDeviceAttributeMultiprocessorCount, dev);
    (void)hipOccupancyMaxActiveBlocksPerMultiprocessor(&per_cu, fwd_kernel, 512, 0);
    if (per_cu < 1) per_cu = 1;
    grid_blocks = 256;
  }
  Params p{};
  p.x = (const float*)d_in[0]; p.pos = (const int*)d_in[1]; p.g_attn_pre = (const float*)d_in[2]; p.w_in = (const float*)d_in[3]; p.g_cq = (const float*)d_in[4];
  p.w_uq = (const float*)d_in[5]; p.g_ckv = (const float*)d_in[6]; p.w_ukv = (const float*)d_in[7]; p.g_out_sb = (const float*)d_in[8]; p.g_out_mla = (const float*)d_in[9];
  p.w_o = (const float*)d_in[10]; p.g_attn_post = (const float*)d_in[11]; p.g_ffn_pre = (const float*)d_in[12]; p.w_up = (const float*)d_in[13]; p.conv_w = (const float*)d_in[14];
  p.conv_b = (const float*)d_in[15]; p.w_down = (const float*)d_in[16]; p.g_ffn_post = (const float*)d_in[17]; p.out = (float*)d_out; p.ws = (char*)d_ws;
  (void)hipMemsetAsync((char*)d_ws + OFF_CNT, 0, 16384, stream);
  void* args[] = {&p};
  hipError_t e = hipLaunchCooperativeKernel((void*)fwd_kernel, dim3(grid_blocks), dim3(512), args, 0, stream);
  if (e != hipSuccess) fprintf(stderr, "cooperative launch failed: %s (grid %d)\n", hipGetErrorString(e), grid_blocks);
}
```

```cpp
#include <hip/hip_runtime.h>
#include <hip/hip_bf16.h>
#include <hip/hip_cooperative_groups.h>
#include <cstdio>
#include <cstdint>
namespace cg = cooperative_groups;

typedef unsigned short bf16_t;
using bf16x8 = __attribute__((ext_vector_type(8))) short;
using s16x4  = __attribute__((ext_vector_type(4))) short;
using f32x4  = __attribute__((ext_vector_type(4))) float;
using f32x16 = __attribute__((ext_vector_type(16))) float;
using u32x4  = __attribute__((ext_vector_type(4))) unsigned;
using u32x2  = __attribute__((ext_vector_type(2))) unsigned;
using i32x4  = __attribute__((ext_vector_type(4))) int;
#define DEV __device__ __forceinline__
#define LDS_AS __attribute__((address_space(3)))
#define GLB_AS __attribute__((address_space(1)))
#define SBAR() __builtin_amdgcn_sched_barrier(0)

constexpr int T_ = 8192, DM = 2048, SEQ = 2048;
constexpr int INC = 3904, INP = 4096, DFF = 5632, DFF2 = 11264;
constexpr float EPS = 1e-6f;
#ifndef PHASES
#define PHASES 0x3ff
#endif
#ifndef REPMASK
#define REPMASK 0
#endif
#define EXTRA_SYNC 0
#define AMP_PHASE -1
#define PH(k) if constexpr ((PHASES >> (k)) & 1) for (int rep_ = 0; rep_ < 1 + ((REPMASK >> (k)) & 1); ++rep_)
constexpr size_t MiB = 1024 * 1024;
constexpr size_t OFF_WIN = 0, OFF_WUQ = 16 * MiB, OFF_WUKV = OFF_WUQ + 3 * MiB / 2, OFF_WO = OFF_WUKV + MiB, OFF_H = OFF_WO + 8 * MiB,
                 OFF_Y = OFF_H + 32 * MiB, OFF_WUP = OFF_Y + 32 * MiB, OFF_WDN = OFF_WUP + 44 * MiB, OFF_UP = OFF_WDN + 22 * MiB,
                 OFF_PROJ = OFF_UP, OFF_Q = OFF_UP + 64 * MiB, OFF_KV = OFF_Q + 24 * MiB, OFF_O = OFF_KV + 32 * MiB, OFF_ACT = OFF_UP, OFF_Y2 = OFF_UP + 88 * MiB, OFF_HB = OFF_UP + 120 * MiB,
                 OFF_COS = OFF_UP + 176 * MiB, OFF_SIN = OFF_COS + MiB, OFF_STC = OFF_SIN + MiB, OFF_STO = OFF_STC + MiB / 2,
                 OFF_STY = OFF_STO + MiB / 2, OFF_STY2 = OFF_STY + MiB, OFF_KR = OFF_STY2 + MiB, OFF_CNT = OFF_KR + MiB, WS_END = OFF_CNT + 16384;

struct Params {
  const float* x; const int* pos; const float* g_attn_pre; const float* w_in; const float* g_cq; const float* w_uq; const float* g_ckv; const float* w_ukv;
  const float* g_out_sb; const float* g_out_mla; const float* w_o; const float* g_attn_post; const float* g_ffn_pre; const float* w_up; const float* conv_w;
  const float* conv_b; const float* w_down; const float* g_ffn_post; float* out; char* ws;
};

DEV unsigned cvtpk(float lo, float hi) { unsigned r; asm volatile("v_cvt_pk_bf16_f32 %0, %1, %2" : "=v"(r) : "v"(lo), "v"(hi)); return r; }
DEV float bf_lo(unsigned w) { return __uint_as_float(w << 16); }
DEV float bf_hi(unsigned w) { return __uint_as_float(w & 0xffff0000u); }
DEV int crow(int r, int hi) { return (r & 3) + 8 * (r >> 2) + 4 * hi; }
DEV int opaque_tid() { int t = threadIdx.x; asm volatile("" : "+v"(t)); return t; }
DEV float wave_sum(float s) {
  s += __shfl_xor(s, 32); s += __shfl_xor(s, 16); s += __shfl_xor(s, 8); s += __shfl_xor(s, 4); s += __shfl_xor(s, 2); s += __shfl_xor(s, 1); return s;
}

DEV const char* uptr(const void* p) {
  const unsigned long long v = (unsigned long long)p;
  const unsigned lo = __builtin_amdgcn_readfirstlane((unsigned)v), hi = __builtin_amdgcn_readfirstlane((unsigned)(v >> 32));
  return (const char*)(((unsigned long long)hi << 32) | lo);
}

#define XB_TMO      128
#define XB_XCNT(j)  (256  + 64 * (j))
#define XB_XSUB(j)  (1280 + 64 * (j))
#define XB_XGEN(j)  (2304 + 64 * (j))
#define XB_TOP      3328
#define XB_TOPGEN   3392
#define XB_QCNT     3456
#define XCD_BAR_WORDS 3520
#define XB_SPIN_CAP (1u << 18)
DEV unsigned xb_ld(unsigned* p)              { return __hip_atomic_load(p, __ATOMIC_RELAXED, __HIP_MEMORY_SCOPE_AGENT); }
DEV unsigned xb_add(unsigned* p, unsigned v) { return __hip_atomic_fetch_add(p, v, __ATOMIC_RELAXED, __HIP_MEMORY_SCOPE_AGENT); }
DEV unsigned xb_xcc_id() { return (unsigned)__builtin_amdgcn_s_getreg((3 << 11) | 20) & 0xFu; }
#define XB_SPIN(cond, bar) do { unsigned _sp = 0; while (cond) { __builtin_amdgcn_s_sleep(1); \
    if ((++_sp & 255u) == 0u) { if (xb_ld(&(bar)[XB_TMO])) break; if (_sp > XB_SPIN_CAP) { atomicAdd(&(bar)[XB_TMO], 1u); break; } } } } while (0)
struct XcdBarrier { unsigned* bar; unsigned x; volatile LDS_AS unsigned* st; };
DEV XcdBarrier xcd_barrier_post(unsigned* bar, volatile LDS_AS unsigned* st) {
  XcdBarrier b; b.bar = bar; b.x = xb_xcc_id(); b.st = st;
  if (threadIdx.x == 0) (void)xb_add(&bar[XB_XCNT(b.x)], 1u);
  return b;
}
DEV void xcd_barrier_complete(unsigned* bar, unsigned x, unsigned& nloc, unsigned& nx) {
  const unsigned G = gridDim.x * gridDim.y * gridDim.z;
  unsigned sum, cnt, mine, sp = 0u;
  for (;;) {
    sum = 0u; cnt = 0u; mine = 0u;
#pragma unroll
    for (unsigned j = 0; j < 16; ++j) { const unsigned c = xb_ld(&bar[XB_XCNT(j)]); sum += c; cnt += (c > 0u) ? 1u : 0u; mine = (j == x) ? c : mine; }
    if (sum == G) break;
    __builtin_amdgcn_s_sleep(1);
    if ((++sp & 255u) == 0u) { if (xb_ld(&bar[XB_TMO])) break; if (sp > XB_SPIN_CAP) { atomicAdd(&bar[XB_TMO], 1u); break; } }
  }
  nloc = mine > 0u ? mine : 1u; nx = cnt > 0u ? cnt : 1u;
}
DEV void xcd_barrier(const XcdBarrier& b) {
  asm volatile("s_waitcnt vmcnt(0)" ::: "memory");
  __syncthreads();
  if (threadIdx.x == 0) {
    unsigned* bar = b.bar;
    __builtin_amdgcn_s_waitcnt(0);
    unsigned nloc = b.st[0], nx = b.st[1];
    if (nloc == 0u) { xcd_barrier_complete(bar, b.x, nloc, nx); b.st[0] = nloc; b.st[1] = nx; }
    const unsigned old = xb_add(&bar[XB_XSUB(b.x)], 1u);
    const unsigned gen = old / nloc;
    if (old + 1u == (gen + 1u) * nloc) {
      __builtin_amdgcn_fence(__ATOMIC_RELEASE, "agent");
      asm volatile("s_waitcnt vmcnt(0)" ::: "memory");
      const unsigned og = xb_add(&bar[XB_TOP], 1u);
      const unsigned tg = og / nx;
      if (og + 1u == (tg + 1u) * nx) xb_add(&bar[XB_TOPGEN], 1u);
      else XB_SPIN(xb_ld(&bar[XB_TOPGEN]) == tg, bar);
      __builtin_amdgcn_fence(__ATOMIC_ACQUIRE, "agent");
      xb_add(&bar[XB_XGEN(b.x)], 1u);
      asm volatile("s_waitcnt vmcnt(0)" ::: "memory");
    } else {
      XB_SPIN(xb_ld(&bar[XB_XGEN(b.x)]) == gen, bar);
      __builtin_amdgcn_fence(__ATOMIC_ACQUIRE, "agent");
      asm volatile("s_waitcnt vmcnt(0)" ::: "memory");
    }
  }
  __syncthreads();
}
DEV int lds_byte2(int r, int c) { int st = (r >> 4) * 2 + (c >> 5), ob = (r & 15) * 64 + (c & 31) * 2; return st * 1024 + (ob ^ (((ob >> 9) & 1) << 5)); }
DEV void stage_rc2(int b, int& R, int& C) { int st = b >> 10, sb = b & 1023, swz = sb ^ (((sb >> 9) & 1) << 5); R = (st >> 1) * 16 + swz / 64; C = (st & 1) * 32 + (swz % 64) / 2; }

DEV float gelu_tanh(float x) {
  const float u = x + 0.044715f * x * x * x;
  return x * __builtin_amdgcn_rcpf(1.f + __builtin_amdgcn_exp2f(-2.302208198f * u));
}

DEV float dpp_shr1(float old, float src) {
  return __int_as_float(__builtin_amdgcn_update_dpp(__float_as_int(old), __float_as_int(src), 0x111, 0xf, 0xf, false));
}
DEV void epi_up(const f32x4 (&acc)[2][2][4][2], int pm, int pn, int wr, int wc, int fr, int fq, float* halo, bf16_t* ACTp, float* HB, const float* conv_w, const float* conv_b) {
  if (fr == 15) {
#pragma unroll
    for (int ai = 0; ai < 2; ++ai)
#pragma unroll
      for (int rs = 0; rs < 2; ++rs)
#pragma unroll
        for (int bj = 0; bj < 2; ++bj)
#pragma unroll
          for (int n = 0; n < 2; ++n) *(f32x4*)(halo + (((ai * 2 + wr) * 4 + wc) * 2 + rs) * 64 + (bj * 2 + n) * 16 + fq * 4) = acc[ai][bj][2 + rs][n];
  }
  {
    GLB_AS char* hb = (GLB_AS char*)uptr(HB);
    if (wr == 1 && fr == 15) {
#pragma unroll
      for (int rs = 0; rs < 2; ++rs)
#pragma unroll
        for (int bj = 0; bj < 2; ++bj)
#pragma unroll
          for (int n = 0; n < 2; ++n) *(GLB_AS f32x4*)(hb + (unsigned)((pm * 4 + rs) * DFF2 + pn * 256 + bj * 128 + wc * 32 + 8 * fq + 4 * n) * 4u) = acc[1][bj][2 + rs][n];
    }
    if (wr == 0 && fr == 0) {
#pragma unroll
      for (int rs = 0; rs < 2; ++rs)
#pragma unroll
        for (int bj = 0; bj < 2; ++bj)
#pragma unroll
          for (int n = 0; n < 2; ++n) *(GLB_AS f32x4*)(hb + (unsigned)((pm * 4 + 2 + rs) * DFF2 + pn * 256 + bj * 128 + wc * 32 + 8 * fq + 4 * n) * 4u) = acc[0][bj][rs][n];
    }
  }
  asm volatile("s_waitcnt lgkmcnt(0)" ::: "memory"); __builtin_amdgcn_s_barrier(); asm volatile("" ::: "memory");
  GLB_AS char* ap = (GLB_AS char*)uptr(ACTp);
#pragma unroll
  for (int n = 0; n < 2; ++n) {
    const int chb = pn * 128 + wc * 32 + 8 * fq + 4 * n;
    const f32x4 wg0 = *(const f32x4*)(conv_w + chb), wg1 = *(const f32x4*)(conv_w + DFF2 + chb), wg2 = *(const f32x4*)(conv_w + 2 * DFF2 + chb), bg = *(const f32x4*)(conv_b + chb);
    const f32x4 wv0 = *(const f32x4*)(conv_w + DFF + chb), wv1 = *(const f32x4*)(conv_w + DFF2 + DFF + chb), wv2 = *(const f32x4*)(conv_w + 2 * DFF2 + DFF + chb), bv = *(const f32x4*)(conv_b + DFF + chb);
#pragma unroll
    for (int ai = 0; ai < 2; ++ai) {
      f32x4 hg2 = {0.f, 0.f, 0.f, 0.f}, hg3 = hg2, hv2 = hg2, hv3 = hg2;
      if ((wr == 1 || ai == 1) && fr == 0) {
        const int sai = wr == 1 ? ai : 0, swr = wr == 1 ? 0 : 1;
        const float* hp = halo + ((sai * 2 + swr) * 4 + wc) * 128 + fq * 4;
        hg2 = *(const f32x4*)(hp + n * 16); hv2 = *(const f32x4*)(hp + (2 + n) * 16); hg3 = *(const f32x4*)(hp + 64 + n * 16); hv3 = *(const f32x4*)(hp + 64 + (2 + n) * 16);
      }
      f32x4 sg2, sg3, sv2, sv3;
#pragma unroll
      for (int j = 0; j < 4; ++j) {
        sg2[j] = dpp_shr1(hg2[j], acc[ai][0][2][n][j]); sg3[j] = dpp_shr1(hg3[j], acc[ai][0][3][n][j]);
        sv2[j] = dpp_shr1(hv2[j], acc[ai][1][2][n][j]); sv3[j] = dpp_shr1(hv3[j], acc[ai][1][3][n][j]);
      }
#pragma unroll
      for (int m = 0; m < 4; ++m) {
        const f32x4 cg = acc[ai][0][m][n], cv = acc[ai][1][m][n];
        const f32x4 g1 = m == 0 ? sg3 : acc[ai][0][m == 0 ? 0 : m - 1][n], g2 = m == 0 ? sg2 : (m == 1 ? sg3 : acc[ai][0][m < 2 ? 0 : m - 2][n]);
        const f32x4 v1 = m == 0 ? sv3 : acc[ai][1][m == 0 ? 0 : m - 1][n], v2 = m == 0 ? sv2 : (m == 1 ? sv3 : acc[ai][1][m < 2 ? 0 : m - 2][n]);
        const f32x4 ug = wg2 * cg + wg1 * g1 + wg0 * g2 + bg, uv = wv2 * cv + wv1 * v1 + wv0 * v2 + bv;
        const int row = pm * 256 + ai * 128 + wr * 64 + 4 * fr + m;
        u32x2 w; w[0] = cvtpk(gelu_tanh(ug[0]) * uv[0], gelu_tanh(ug[1]) * uv[1]); w[1] = cvtpk(gelu_tanh(ug[2]) * uv[2], gelu_tanh(ug[3]) * uv[3]);
        *(GLB_AS u32x2*)(ap + (unsigned)(row * DFF + chb) * 2u) = w;
      }
      asm volatile("" ::: "memory");
    }
  }
}

DEV int perm32(int rho) { const int n = rho >> 4, i = rho & 15; return 8 * (i >> 2) + 4 * n + (i & 3); }
struct Unit { int pm, pn; };
struct Sched {
  int nN, nUnits, G, c;
  DEV bool next(int i, Unit& u) const { const int L = i * G + c; if (L >= nUnits) return false; u.pm = (L & 15) + 16 * (L / (16 * nN)); u.pn = (L >> 4) % nN; return true; }
};
template <int MODE> struct Epi {
  bf16_t* out; int ldo; const float* st_in; float* st_out; bf16_t* outK; bf16_t* outV;
  DEV void prep(float* rsc, int row0, int tid) const {
    if (tid < 256) {
      const float* sp = st_in + (size_t)(row0 + tid) * 16;
      const f32x4 a0 = *(const f32x4*)(sp), a1 = *(const f32x4*)(sp + 4), b0 = *(const f32x4*)(sp + 8), b1 = *(const f32x4*)(sp + 12);
      const float ssb = (a0[0] + a0[1]) + (a0[2] + a0[3]) + (a1[0] + a1[1]) + (a1[2] + a1[3]);
      const float sml = (b0[0] + b0[1]) + (b0[2] + b0[3]) + (b1[0] + b1[1]) + (b1[2] + b1[3]);
      const float rsb = rsqrtf(ssb * (1.f / 1024.f) + EPS), rml = rsqrtf(sml * (1.f / 1024.f) + EPS);
      rsc[tid] = rsb / rml; rsc[256 + tid] = rml;
    }
  }
  DEV void hook(f32x4 (&acc)[2][2][4][2], const float* rsc, int wr, int fr) const {
#pragma unroll
    for (int ai = 0; ai < 2; ++ai)
#pragma unroll
      for (int m = 0; m < 4; ++m) {
        const float ratio = rsc[ai * 128 + wr * 64 + m * 16 + fr];
#pragma unroll
        for (int bj = 0; bj < 2; ++bj)
#pragma unroll
          for (int n = 0; n < 2; ++n) acc[ai][bj][m][n] *= ratio;
      }
  }
  DEV void operator()(const f32x4 (&acc)[2][2][4][2], int pm, int pn, int wr, int wc, int fr, int fq, const float* rsc) const {
    const bool do_stat = MODE == 0 ? (pn >= 12 && pn < 15) : (MODE == 3 || MODE == 5);
    const int slot = MODE == 0 ? ((pn - 12) * 4 + wc) : (pn * 4 + wc);
    constexpr int SS = MODE == 0 ? 16 : 32;
    GLB_AS char* ob = (GLB_AS char*)uptr(out);
#pragma unroll
    for (int ai = 0; ai < 2; ++ai)
#pragma unroll
      for (int m = 0; m < 4; ++m) {
        const int rloc = ai * 128 + wr * 64 + m * 16 + fr, row = pm * 256 + rloc;
        float rs = (MODE == 0 && pn < 4) ? 0.08838834764831845f * 1.4426950408889634f : 1.f;
        if (MODE == 1) { const float* sp = st_in + (size_t)row * 16; const f32x4 a0 = *(const f32x4*)(sp), a1 = *(const f32x4*)(sp + 4);
          rs = rsqrtf(((a0[0] + a0[1]) + (a0[2] + a0[3]) + (a1[0] + a1[1]) + (a1[2] + a1[3])) * (1.f / 512.f) + EPS); }
        if (MODE == 2) { const f32x4 a0 = *(const f32x4*)(st_in + (size_t)row * 16 + 8); rs = rsqrtf(((a0[0] + a0[1]) + (a0[2] + a0[3])) * (1.f / 256.f) + EPS); }
        if (MODE == 3) rs = rsc[256 + rloc];
        f32x4 v[2][2];
#pragma unroll
        for (int bj = 0; bj < 2; ++bj)
#pragma unroll
          for (int n = 0; n < 2; ++n) v[bj][n] = acc[ai][bj][m][n] * rs;
        if (MODE == 0 || MODE == 3 || MODE == 5) {
          if (do_stat) {
            float s = 0.f;
#pragma unroll
            for (int bj = 0; bj < 2; ++bj)
#pragma unroll
              for (int n = 0; n < 2; ++n) s += (v[bj][n][0] * v[bj][n][0] + v[bj][n][1] * v[bj][n][1]) + (v[bj][n][2] * v[bj][n][2] + v[bj][n][3] * v[bj][n][3]);
            s += __shfl_xor(s, 16); s += __shfl_xor(s, 32);
            *(GLB_AS float*)((GLB_AS char*)uptr(st_out) + (unsigned)(row * SS + slot) * 4u) = s;
          }
        }
        u32x4 w[2];
#pragma unroll
        for (int bj = 0; bj < 2; ++bj) { w[bj][0] = cvtpk(v[bj][0][0], v[bj][0][1]); w[bj][1] = cvtpk(v[bj][0][2], v[bj][0][3]); w[bj][2] = cvtpk(v[bj][1][0], v[bj][1][1]); w[bj][3] = cvtpk(v[bj][1][2], v[bj][1][3]); }
        if (MODE == 0 && pn >= 4 && pn < 12) {
          GLB_AS char* hb_ = (GLB_AS char*)uptr(pn < 8 ? outK : outV);
#pragma unroll
          for (int bj = 0; bj < 2; ++bj) { const int hh = (pn & 3) * 2 + bj;
            *(GLB_AS u32x4*)(hb_ + (unsigned)((((row >> 11) * 8 + hh) * 2048 + (row & 2047)) * 128 + wc * 32 + 8 * fq) * 2u) = w[bj]; }
        } else if (MODE == 2) {
          const unsigned ho = (unsigned)((((row >> 11) * 8 + pn) * 2048 + (row & 2047)) * 128 + wc * 32 + 8 * fq) * 2u;
          *(GLB_AS u32x4*)((GLB_AS char*)uptr(outK) + ho) = w[0]; *(GLB_AS u32x4*)((GLB_AS char*)uptr(outV) + ho) = w[1];
        } else {
          const unsigned oo = (unsigned)(row * ldo + pn * 256 + wc * 32 + 8 * fq) * 2u;
          *(GLB_AS u32x4*)(ob + oo) = w[0]; *(GLB_AS u32x4*)(ob + oo + 256) = w[1];
        }
        asm volatile("" ::: "memory");
      }
  }
};

template <int MODE>
DEV void gemm_phase(char* shm, float* rowsc, const bf16_t* __restrict__ A, int lda, const bf16_t* __restrict__ Bt, int K, int nN, const Epi<MODE>& E,
                    float* halo = nullptr, float* HBp = nullptr, const float* conv_w = nullptr, const float* conv_b = nullptr) {
  constexpr int HALF = 128, HTB = HALF * 64 * 2;
  LDS_AS unsigned char* lds = (LDS_AS unsigned char*)shm;
  const int tid = opaque_tid(), wid = __builtin_amdgcn_readfirstlane(tid >> 6), lane = tid & 63, wr = wid >> 2, wc = wid & 3, fr = lane & 15, fq = lane >> 4;
  const int nt = K / 64;
  Sched S; S.nN = nN; S.nUnits = 32 * nN; S.G = gridDim.x; S.c = blockIdx.x;
  unsigned voffA[2], voffB[2];
#pragma unroll
  for (int i = 0; i < 2; ++i) { int R, C; stage_rc2(tid * 16 + i * 8192, R, C); const int Rb = (R & ~31) + perm32(R & 31);
    const int Ra = MODE == 4 ? ((R & 64) | ((R & 15) << 2) | ((R >> 4) & 3)) : R;
    voffA[i] = (unsigned)(Ra * lda + C) * 2u; voffB[i] = (unsigned)(Rb * K + C) * 2u; }
  const size_t kstep = 128;
  const size_t hstepA = (size_t)HALF * lda * 2, hstepB = (size_t)HALF * K * 2, tstepA = 2 * hstepA, tstepB = 2 * hstepB;
  const unsigned ldsw = (unsigned)wid * 1024u;
  const int aoff = lds_byte2(wr * 64 + fr, fq * 8), boff = lds_byte2(wc * 32 + fr, fq * 8);
  LDS_AS unsigned char* pa = lds + aoff; LDS_AS unsigned char* pb = lds + 4 * HTB + boff;
  asm volatile("" : "+v"(pa), "+v"(pb));
#define PG8_SA(b, h) (((b) * 2 + (h)) * HTB)
#define PG8_SB(b, h) ((4 + (b) * 2 + (h)) * HTB)
#define PG8_STAGE(bufoff, gbase, voff) do { const char* gb_ = uptr(gbase); _Pragma("unroll") for (int _i = 0; _i < 2; ++_i) \
        __builtin_amdgcn_global_load_lds((const unsigned*)(gb_ + (voff)[_i]), (LDS_AS unsigned*)(lds + (bufoff) + ldsw + _i * 8192), 16, 0, 0); } while (0)
#define PG8_LDA(dst, b, h) do { _Pragma("unroll") for (int m = 0; m < 4; ++m) _Pragma("unroll") for (int k = 0; k < 2; ++k) dst[m][k] = *(const LDS_AS bf16x8*)(pa + (PG8_SA(b, h) + m * 2048 + k * 1024)); } while (0)
#define PG8_LDB(dst, b, h) do { _Pragma("unroll") for (int n = 0; n < 2; ++n) _Pragma("unroll") for (int k = 0; k < 2; ++k) dst[n][k] = *(const LDS_AS bf16x8*)(pb + (PG8_SA(b, h) + n * 2048 + k * 1024)); } while (0)
#define PG8_MMA(ai, bj, At, Bt_) do { __builtin_amdgcn_s_setprio(1); _Pragma("unroll") for (int m = 0; m < 4; ++m) _Pragma("unroll") for (int n = 0; n < 2; ++n) _Pragma("unroll") for (int k = 0; k < 2; ++k) \
        acc[ai][bj][m][n] = __builtin_amdgcn_mfma_f32_16x16x32_bf16(Bt_[n][k], At[m][k], acc[ai][bj][m][n], 0, 0, 0); __builtin_amdgcn_s_setprio(0); } while (0)
#define PG8_WAIT_V(n) asm volatile("s_waitcnt vmcnt(" #n ")" ::: "memory")
#define PG8_WAIT_L(n) asm volatile("s_waitcnt lgkmcnt(" #n ")" ::: "memory")
#define PG8_BAR __builtin_amdgcn_s_barrier()
#define PG8_SCHED __builtin_amdgcn_sched_barrier(0)
  Unit cur, nxt; int ui = 0;
  if (!S.next(0, cur)) return;
  f32x4 acc[2][2][4][2];
#pragma unroll
  for (int a = 0; a < 2; ++a)
#pragma unroll
    for (int b = 0; b < 2; ++b)
#pragma unroll
      for (int m = 0; m < 4; ++m)
#pragma unroll
        for (int n = 0; n < 2; ++n) acc[a][b][m][n] = (f32x4){0.f, 0.f, 0.f, 0.f};
  bf16x8 At[4][2], B0[2][2], B1[2][2];
  const char* cA = (const char*)A + (size_t)cur.pm * tstepA; const char* cB = (const char*)Bt + (size_t)cur.pn * tstepB;
  if (MODE == 3) E.prep(rowsc, cur.pm * 256, tid);
  PG8_STAGE(PG8_SB(0, 0), cB, voffB); PG8_STAGE(PG8_SB(0, 1), cB + hstepB, voffB); PG8_STAGE(PG8_SA(0, 0), cA, voffA); PG8_STAGE(PG8_SA(0, 1), cA + hstepA, voffA);
  if (wr == 1) PG8_BAR;
  PG8_WAIT_V(2); PG8_BAR;
  PG8_STAGE(PG8_SB(1, 0), cB + kstep, voffB); PG8_STAGE(PG8_SA(1, 0), cA + kstep, voffA); PG8_STAGE(PG8_SB(1, 1), cB + hstepB + kstep, voffB);
  PG8_WAIT_V(6); PG8_BAR;
  for (;;) {
    const bool has_next = S.next(ui + 1, nxt);
    const char* nA = has_next ? (const char*)A + (size_t)nxt.pm * tstepA : cA; const char* nB = has_next ? (const char*)Bt + (size_t)nxt.pn * tstepB : cB;
    const float* rsc = rowsc + (ui & 1) * 512;
    for (int t = 0; t < nt; t += 2) {
      const bool last = (t == nt - 2);
      const char* a1 = cA + (size_t)(t + 1) * kstep;
      const char* a2 = last ? nA : cA + (size_t)(t + 2) * kstep; const char* b2 = last ? nB : cB + (size_t)(t + 2) * kstep;
      const char* a3 = a2 + kstep; const char* b3 = b2 + kstep;
      if (MODE == 3) { if (t == 16) E.hook(acc, rsc, wr, fr); }
      PG8_LDB(B0, 0, 0); PG8_LDB(B1, 0, 1); PG8_SCHED; PG8_LDA(At, 0, 0); PG8_STAGE(PG8_SA(1, 1), a1 + hstepA, voffA);
      PG8_WAIT_V(8); PG8_WAIT_L(0); PG8_BAR; PG8_MMA(0, 0, At, B0); PG8_MMA(0, 1, At, B1); PG8_BAR; PG8_SCHED;
      PG8_LDA(At, 0, 1); PG8_STAGE(PG8_SB(0, 0), b2, voffB); PG8_STAGE(PG8_SB(0, 1), b2 + hstepB, voffB); PG8_STAGE(PG8_SA(0, 0), a2, voffA);
      PG8_WAIT_V(8); PG8_WAIT_L(0); PG8_BAR; PG8_MMA(1, 0, At, B0); PG8_MMA(1, 1, At, B1); PG8_BAR; PG8_SCHED;
      PG8_LDB(B0, 1, 0); PG8_LDB(B1, 1, 1); PG8_SCHED; PG8_LDA(At, 1, 0); PG8_STAGE(PG8_SA(0, 1), a2 + hstepA, voffA);
      PG8_WAIT_V(8); PG8_WAIT_L(0); PG8_BAR; PG8_MMA(0, 0, At, B0); PG8_MMA(0, 1, At, B1); PG8_BAR; PG8_SCHED;
      PG8_LDA(At, 1, 1); PG8_STAGE(PG8_SB(1, 0), b3, voffB); PG8_STAGE(PG8_SB(1, 1), b3 + hstepB, voffB); PG8_STAGE(PG8_SA(1, 0), a3, voffA);
      PG8_WAIT_V(8); PG8_WAIT_L(0); PG8_BAR; PG8_MMA(1, 0, At, B0); PG8_MMA(1, 1, At, B1); PG8_BAR; PG8_SCHED;
    }
    if (wr == 0) PG8_BAR;
    { const int t2 = opaque_tid();
      if (MODE == 4) epi_up(acc, cur.pm, cur.pn, (t2 >> 8) & 1, (t2 >> 6) & 3, t2 & 15, (t2 >> 4) & 3, halo, E.out, HBp, conv_w, conv_b);
      else E(acc, cur.pm, cur.pn, (t2 >> 8) & 1, (t2 >> 6) & 3, t2 & 15, (t2 >> 4) & 3, rsc); }
    if (!has_next) break;
#pragma unroll
    for (int a = 0; a < 2; ++a)
#pragma unroll
      for (int b = 0; b < 2; ++b)
#pragma unroll
        for (int m = 0; m < 4; ++m)
#pragma unroll
          for (int n = 0; n < 2; ++n) acc[a][b][m][n] = (f32x4){0.f, 0.f, 0.f, 0.f};
    cur = nxt; cA = nA; cB = nB; ++ui;
    if (MODE == 3) E.prep(rowsc + (ui & 1) * 512, cur.pm * 256, tid);
    if (wr == 1) PG8_BAR;
  }
  PG8_WAIT_V(0);
  PG8_BAR;
#undef PG8_SA
#undef PG8_SB
#undef PG8_STAGE
#undef PG8_LDA
#undef PG8_LDB
#undef PG8_MMA
#undef PG8_WAIT_V
#undef PG8_WAIT_L
#undef PG8_BAR
#undef PG8_SCHED
}

DEV int v_st(int k, int c) { const int kk = (k & ~0xC) | ((k & 4) << 1) | ((k & 8) >> 1); return ((kk >> 3) * 4 + (c >> 5)) * 512 + ((kk & 7) * 32 + (c & 31)) * 2; }
DEV int v_rd_base(int lane) { return ((lane & 3) << 3) | (((lane >> 2) & 3) << 6) | (((lane >> 4) & 1) << 5) | (((lane >> 5) & 1) << 8); }
constexpr int v_rd_off(int d0, int ks, int half) { return d0 * 512 + ks * 4096 + half * 2048; }
template <int OFF> DEV s16x4 tr_read(int vb) { s16x4 r; asm volatile("ds_read_b64_tr_b16 %0, %1 offset:%2" : "=&v"(r) : "v"(vb), "i"(OFF) : "memory"); return r; }
template <int D0> DEV void pv_one(f32x16& od, int vb, bf16x8 pa0, bf16x8 pa1, bf16x8 pa2, bf16x8 pa3) {
  const s16x4 l0 = tr_read<v_rd_off(D0, 0, 0)>(vb), h0 = tr_read<v_rd_off(D0, 0, 1)>(vb), l1 = tr_read<v_rd_off(D0, 1, 0)>(vb), h1 = tr_read<v_rd_off(D0, 1, 1)>(vb);
  const s16x4 l2 = tr_read<v_rd_off(D0, 2, 0)>(vb), h2 = tr_read<v_rd_off(D0, 2, 1)>(vb), l3 = tr_read<v_rd_off(D0, 3, 0)>(vb), h3 = tr_read<v_rd_off(D0, 3, 1)>(vb);
  asm volatile("s_waitcnt lgkmcnt(0)" ::: "memory"); SBAR();
#define PKV(L, H) (bf16x8){L[0], L[1], L[2], L[3], H[0], H[1], H[2], H[3]}
  od = __builtin_amdgcn_mfma_f32_32x32x16_bf16(pa0, PKV(l0, h0), od, 0, 0, 0);
  od = __builtin_amdgcn_mfma_f32_32x32x16_bf16(pa1, PKV(l1, h1), od, 0, 0, 0);
  od = __builtin_amdgcn_mfma_f32_32x32x16_bf16(pa2, PKV(l2, h2), od, 0, 0, 0);
  od = __builtin_amdgcn_mfma_f32_32x32x16_bf16(pa3, PKV(l3, h3), od, 0, 0, 0);
#undef PKV
}
#define PK4(P, BASE, OUT) do { unsigned a0_ = cvtpk(P[BASE + 0], P[BASE + 1]), a1_ = cvtpk(P[BASE + 2], P[BASE + 3]);   \
    unsigned b0_ = cvtpk(P[BASE + 4], P[BASE + 5]), b1_ = cvtpk(P[BASE + 6], P[BASE + 7]);                              \
    auto r0_ = __builtin_amdgcn_permlane32_swap(a0_, b0_, false, false); auto r1_ = __builtin_amdgcn_permlane32_swap(a1_, b1_, false, false); \
    u32x4 w_ = {r0_[0], r1_[0], r0_[1], r1_[1]}; OUT = *reinterpret_cast<bf16x8*>(&w_); } while (0)

DEV void sb_half(f32x16& P, float& run, bool diag, int key0, int qrow, int hi) {
  constexpr float C = 0.08838834764831845f * 1.4426950408889634f;
#pragma unroll
  for (int r = 0; r < 16; ++r) P[r] = fmaxf(P[r], -100.f);
  if (diag) {
#pragma unroll
    for (int r = 0; r < 16; ++r) { if (key0 + crow(r, hi) >= qrow) P[r] = -100.f; }
  }
  f32x16 L;
#pragma unroll
  for (int r = 0; r < 16; ++r) { const float em = __builtin_amdgcn_exp2f(-P[r]); const float be = __builtin_amdgcn_rcpf(1.f + em); P[r] = be; L[r] = em * be; }
#pragma unroll
  for (int g = 3; g >= 0; --g) {
    const float gs = (L[4 * g] * L[4 * g + 1]) * (L[4 * g + 2] * L[4 * g + 3]);
    auto rr = __builtin_amdgcn_permlane32_swap(__float_as_uint(gs), __float_as_uint(gs), false, false);
    const float lo = __uint_as_float(rr[0]), hv = __uint_as_float(rr[1]);
    const float e3 = run * (hi == 0 ? hv : 1.f), e2 = e3 * L[4 * g + 3], e1 = e2 * L[4 * g + 2], e0 = e1 * L[4 * g + 1];
    run *= lo * hv;
    P[4 * g + 3] *= e3; P[4 * g + 2] *= e2; P[4 * g + 1] *= e1; P[4 * g + 0] *= e0;
  }
}
DEV void sb_tile(f32x16& p0, f32x16& p1, float& carry, bool diag, int kt0, int qrow, int hi) {
  sb_half(p1, carry, diag, kt0 + 32, qrow, hi);
  sb_half(p0, carry, diag, kt0, qrow, hi);
}

template <bool MLA>
DEV void attn_unit(char* lds, const bf16_t* __restrict__ Qb, int ldq, const bf16_t* __restrict__ Kb, int ldk, const bf16_t* __restrict__ Krb, int ldkr,
                   const bf16_t* __restrict__ Vb, int ldv, bf16_t* __restrict__ Ob, int ldo, float* __restrict__ statb, int qb, const float* __restrict__ cosb, const float* __restrict__ sinb) {
  constexpr int DQ = MLA ? 192 : 128, ND = DQ / 16, ROWB = DQ * 2, SHMK = 64 * ROWB, SHMV = 16384, VOFF = 2 * SHMK, SCR = VOFF + 3 * SHMV;
#define KSWZ(row, colB) ((row) * ROWB + ((colB) ^ (((row) & 7) << 4)))
  const int tid = opaque_tid(), wid = tid >> 6, lane = tid & 63, r32 = lane & 31, hi = lane >> 5;
  float* al_l = (float*)(lds + SCR + wid * 256); float* li_l = al_l + 32;
  char* qlds = lds + SCR + 2048 + wid * 4096 + lane * 16;
  const int q0w = 256 * qb + 32 * wid, qrow = q0w + r32;
  bf16x8 qr[ND];
  { const bf16_t* Qw = Qb + (size_t)qrow * ldq + hi * 8;
#pragma unroll
    for (int d0 = 0; d0 < ND; ++d0) qr[d0] = *(const bf16x8*)(Qw + d0 * 16); }
  if (MLA) {
#pragma unroll
    for (int dd = 0; dd < 2; ++dd) {
      const float* cp = cosb + (size_t)qrow * 32 + dd * 16 + hi * 8; const float* sp = sinb + (size_t)qrow * 32 + dd * 16 + hi * 8;
      const f32x4 c0 = *(const f32x4*)cp, c1 = *(const f32x4*)(cp + 4), s0 = *(const f32x4*)sp, s1 = *(const f32x4*)(sp + 4);
      const u32x4 a = __builtin_bit_cast(u32x4, qr[ND - 4 + dd]), b = __builtin_bit_cast(u32x4, qr[ND - 2 + dd]);
      u32x4 ya, yb;
#pragma unroll
      for (int q = 0; q < 4; ++q) {
        const float cl = q < 2 ? c0[2 * q] : c1[2 * q - 4], ch = q < 2 ? c0[2 * q + 1] : c1[2 * q - 3];
        const float sl = q < 2 ? s0[2 * q] : s1[2 * q - 4], sh = q < 2 ? s0[2 * q + 1] : s1[2 * q - 3];
        const float x1l = bf_lo(a[q]), x1h = bf_hi(a[q]), x2l = bf_lo(b[q]), x2h = bf_hi(b[q]);
        ya[q] = cvtpk(x1l * cl - x2l * sl, x1h * ch - x2h * sh); yb[q] = cvtpk(x1l * sl + x2l * cl, x1h * sh + x2h * ch);
      }
      qr[ND - 4 + dd] = __builtin_bit_cast(bf16x8, ya); qr[ND - 2 + dd] = __builtin_bit_cast(bf16x8, yb);
    }
#pragma unroll
    for (int d = 0; d < 4; ++d) *(bf16x8*)(qlds + d * 1024) = qr[ND - 4 + d];
  }
  f32x16 o[4];
#pragma unroll
  for (int d = 0; d < 4; ++d)
#pragma unroll
    for (int r = 0; r < 16; ++r) o[d][r] = 0.f;
  float carry = 1.f, m_reg = -1e30f, l_reg = 0.f;
  const int NT = 4 * qb + 4, jmax = 4 * qb + (wid >> 1);
  const int sr = tid >> 4, sc = (tid & 15) * 8, vst0 = v_st(sr, sc), vst1 = v_st(32 + sr, sc), krr = tid >> 3, krc = (tid & 7) * 8;
  const int vb0 = (int)(unsigned)(uintptr_t)(lds + VOFF) + v_rd_base(lane);
  bf16x8 ks0, ks1, vs0, vs1, kx;
#define A_LOAD(jt) do { const int kt0_ = (jt) * 64; \
    ks0 = *(const bf16x8*)(Kb + (size_t)(kt0_ + sr) * ldk + sc); ks1 = *(const bf16x8*)(Kb + (size_t)(kt0_ + 32 + sr) * ldk + sc); \
    vs0 = *(const bf16x8*)(Vb + (size_t)(kt0_ + sr) * ldv + sc); vs1 = *(const bf16x8*)(Vb + (size_t)(kt0_ + 32 + sr) * ldv + sc); \
    if (MLA) kx = *(const bf16x8*)(Krb + (size_t)(kt0_ + krr) * ldkr + krc); SBAR(); } while (0)
#define A_WRITE(kb, vslot) do { char* base_ = lds + (kb) * SHMK; char* vbase_ = lds + VOFF + (vslot) * SHMV; \
    *(bf16x8*)(base_ + KSWZ(sr, sc * 2)) = ks0; *(bf16x8*)(base_ + KSWZ(32 + sr, sc * 2)) = ks1; \
    *(bf16x8*)(vbase_ + vst0) = vs0; *(bf16x8*)(vbase_ + vst1) = vs1; \
    if (MLA) *(bf16x8*)(base_ + KSWZ(krr, (128 + krc) * 2)) = kx; } while (0)
#define A_PV(vslot) do { const int vb_ = vb0 + (vslot) * SHMV; \
    pv_one<0>(o[0], vb_, pa0, pa1, pa2, pa3); pv_one<1>(o[1], vb_, pa0, pa1, pa2, pa3); pv_one<2>(o[2], vb_, pa0, pa1, pa2, pa3); pv_one<3>(o[3], vb_, pa0, pa1, pa2, pa3); } while (0)
  const bool late = wid >= 4; bool pend = false;
  bool done_w = false; int* dflag = (int*)(lds + SCR + 2048);
  bf16x8 pa0, pa1, pa2, pa3;
  A_LOAD(NT - 1); A_WRITE(0, 0); A_LOAD(NT - 2); __syncthreads();
  int vs = 0;
  for (int i = 0; i < NT; ++i) {
    const int jt = NT - 1 - i, cur = i & 1, vnext = vs == 2 ? 0 : vs + 1, vprev = vs == 0 ? 2 : vs - 1;
    if (i + 1 < NT) A_WRITE(cur ^ 1, vnext);
    if (late && pend) { A_PV(vprev); pend = false; }
    if (jt > jmax || done_w) { if (i + 2 < NT) A_LOAD(jt - 2); }
    else {
      const char* Kl = lds + cur * SHMK;
      f32x16 p0, p1;
#pragma unroll
      for (int r = 0; r < 16; ++r) { p0[r] = 0.f; p1[r] = 0.f; }
      {
        bf16x8 kb0[4], kb1[4], qb0[2], qb1[2];
#define QK_LOAD(KB, QB, bt) do { _Pragma("unroll") for (int u_ = 0; u_ < 2; ++u_) { const int d0_ = 2 * (bt) + u_; const int cb_ = (d0_ * 16 + hi * 8) * 2; \
          KB[2 * u_] = *(const bf16x8*)(Kl + KSWZ(r32, cb_)); KB[2 * u_ + 1] = *(const bf16x8*)(Kl + KSWZ(32 + r32, cb_)); \
          if (MLA && d0_ >= 8) QB[u_] = *(const bf16x8*)(qlds + (d0_ - 8) * 1024); else QB[u_] = qr[d0_ < 8 ? d0_ : 0]; } } while (0)
#define QK_MMA(KB, QB) do { _Pragma("unroll") for (int u_ = 0; u_ < 2; ++u_) { \
          p0 = __builtin_amdgcn_mfma_f32_32x32x16_bf16(KB[2 * u_], QB[u_], p0, 0, 0, 0); p1 = __builtin_amdgcn_mfma_f32_32x32x16_bf16(KB[2 * u_ + 1], QB[u_], p1, 0, 0, 0); } } while (0)
        QK_LOAD(kb0, qb0, 0); SBAR();
#pragma unroll
        for (int bt = 0; bt < ND / 2; bt += 2) {
          QK_LOAD(kb1, qb1, bt + 1); SBAR();
          QK_MMA(kb0, qb0); SBAR();
          if (bt + 2 < ND / 2) { QK_LOAD(kb0, qb0, bt + 2); SBAR(); }
          QK_MMA(kb1, qb1); SBAR();
        }
#undef QK_LOAD
#undef QK_MMA
      }
      if (MLA) {
        constexpr float C2 = 0.07216878364870323f * 1.4426950408889634f;
        float pmax = p0[0];
#pragma unroll
        for (int r = 1; r < 16; ++r) pmax = fmaxf(pmax, p0[r]);
#pragma unroll
        for (int r = 0; r < 16; ++r) pmax = fmaxf(pmax, p1[r]);
        { auto rr = __builtin_amdgcn_permlane32_swap(__float_as_uint(pmax), __float_as_uint(pmax), false, false);
          pmax = fmaxf(__uint_as_float(rr[0]), __uint_as_float(rr[1])); }
        float mn, alpha;
        if (__all(pmax - m_reg <= 8.f / 0.07216878364870323f)) { mn = m_reg; alpha = 1.f; }
        else { mn = fmaxf(m_reg, pmax); alpha = __builtin_amdgcn_exp2f((m_reg - mn) * C2); m_reg = mn; }
        const float mnC = -mn * C2;
        float ps = 0.f;
#pragma unroll
        for (int r = 0; r < 16; ++r) { p0[r] = __builtin_amdgcn_exp2f(fmaf(p0[r], C2, mnC)); p1[r] = __builtin_amdgcn_exp2f(fmaf(p1[r], C2, mnC)); ps += p0[r] + p1[r]; }
        { auto rr = __builtin_amdgcn_permlane32_swap(__float_as_uint(ps), __float_as_uint(ps), false, false);
          ps = __uint_as_float(rr[0]) + __uint_as_float(rr[1]); }
        l_reg = l_reg * alpha + ps;
        if (__any(alpha < 1.f)) {
          if (hi == 0) al_l[r32] = alpha;
          asm volatile("s_waitcnt lgkmcnt(0)" ::: "memory");
#pragma unroll
          for (int r = 0; r < 16; ++r) { const float a = al_l[crow(r, hi)];
#pragma unroll
            for (int d = 0; d < 4; ++d) o[d][r] *= a; }
        }
      } else {
        sb_tile(p0, p1, carry, jt == jmax, jt * 64, qrow, hi);
        done_w = __all(carry < 1e-18f);
      }
      PK4(p0, 0, pa0); PK4(p0, 8, pa1); PK4(p1, 0, pa2); PK4(p1, 8, pa3);
      if (i + 2 < NT) A_LOAD(jt - 2);
      if (late) pend = true; else A_PV(vs);
    }
    if (!MLA) { if (lane == 0) dflag[(i & 1) * 8 + wid] = done_w ? 1 : 0; }
    __syncthreads();
    vs = vnext;
    if (!MLA) {
      const int* df = dflag + (i & 1) * 8;
      if ((df[0] & df[1] & df[2] & df[3] & df[4] & df[5] & df[6] & df[7]) != 0) break;
    }
  }
  if (late && pend) { const int vlast = vs == 0 ? 2 : vs - 1; A_PV(vlast); }
  __syncthreads();
  if (MLA) {
    if (hi == 0) li_l[r32] = l_reg;
    asm volatile("s_waitcnt lgkmcnt(0)" ::: "memory");
#pragma unroll
    for (int r = 0; r < 16; ++r) { const float rl = __builtin_amdgcn_rcpf(li_l[crow(r, hi)]);
#pragma unroll
      for (int d = 0; d < 4; ++d) o[d][r] *= rl; }
  }
#pragma unroll
  for (int r = 0; r < 16; ++r) {
    const int orow = q0w + crow(r, hi);
    float s = (o[0][r] * o[0][r] + o[1][r] * o[1][r]) + (o[2][r] * o[2][r] + o[3][r] * o[3][r]);
    s += __shfl_xor(s, 16); s += __shfl_xor(s, 8); s += __shfl_xor(s, 4); s += __shfl_xor(s, 2); s += __shfl_xor(s, 1);
    if (r32 == 0) statb[(size_t)orow * 16] = s;
#pragma unroll
    for (int d = 0; d < 4; ++d) Ob[(size_t)orow * ldo + d * 32 + r32] = (bf16_t)(cvtpk(o[d][r], o[d][r]) & 0xffffu);
  }
#undef A_LOAD
#undef A_WRITE
#undef A_PV
#undef KSWZ
}

struct TrTile { const float* src; bf16_t* dst; const float* g; int K, N, k0, n0, perm; };
DEV TrTile tr_decode(const Params& p, char* ws, int ti) {
  TrTile t; t.g = nullptr; t.perm = 0; int ntn, loc;
  if (ti < 512) { t.src = p.w_in; t.dst = (bf16_t*)(ws + OFF_WIN); t.K = 2048; t.N = INC; ntn = 16; loc = ti; }
  else if (ti < 560) { t.src = p.w_uq; t.dst = (bf16_t*)(ws + OFF_WUQ); t.g = p.g_cq; t.K = 512; t.N = 1536; ntn = 6; loc = ti - 512; }
  else if (ti < 592) { t.src = p.w_ukv; t.dst = (bf16_t*)(ws + OFF_WUKV); t.g = p.g_ckv; t.K = 256; t.N = 2048; ntn = 8; loc = ti - 560; }
  else if (ti < 848) { t.src = p.w_o; t.dst = (bf16_t*)(ws + OFF_WO); t.K = 2048; t.N = 2048; ntn = 8; loc = ti - 592; }
  else if (ti < 2256) { t.src = p.w_up; t.dst = (bf16_t*)(ws + OFF_WUP); t.K = 2048; t.N = DFF2; ntn = 44; loc = ti - 848; t.perm = 1; }
  else { t.src = p.w_down; t.dst = (bf16_t*)(ws + OFF_WDN); t.K = DFF; t.N = 2048; ntn = 8; loc = ti - 2256; }
  const int kt = loc / ntn; t.k0 = kt * 64; t.n0 = (loc % ntn) * 256;
  if (ti >= 592 && ti < 848) t.g = (kt < 16) ? p.g_out_sb : (p.g_out_mla - 1024);
  return t;
}
DEV void tr_load(const TrTile& t, f32x4 (&v)[8], int tid) {
  const int n4 = (tid & 63) * 4, kr = tid >> 6;
#pragma unroll
  for (int i = 0; i < 8; ++i) {
    const int k = kr + 8 * i; v[i] = (f32x4){0.f, 0.f, 0.f, 0.f};
    if (t.n0 + n4 < t.N) v[i] = __builtin_nontemporal_load((const f32x4*)(t.src + (size_t)(t.k0 + k) * t.N + t.n0 + n4));
  }
}
DEV void tr_to_lds(const TrTile& t, const f32x4 (&v)[8], float* tile, int tid) {
  const int n4 = (tid & 63) * 4, kr = tid >> 6;
#pragma unroll
  for (int i = 0; i < 8; ++i) { const int k = kr + 8 * i; f32x4 x = v[i]; if (t.g) x *= t.g[t.k0 + k]; *(f32x4*)(tile + k * 260 + n4) = x; }
}
DEV void tr_store(const TrTile& t, const float* tile, int tid) {
  const int n = tid >> 1, kh = (tid & 1) * 32;
#pragma unroll
  for (int q = 0; q < 4; ++q) {
    u32x4 w;
#pragma unroll
    for (int j = 0; j < 4; ++j) w[j] = cvtpk(tile[(kh + 8 * q + 2 * j) * 260 + n], tile[(kh + 8 * q + 2 * j + 1) * 260 + n]);
    int dn = t.n0 + n;
    if (t.perm) { const int bj = dn >= DFF ? 1 : 0, ch = dn - bj * DFF; dn = (ch >> 7) * 256 + bj * 128 + (ch & 127); }
    *(u32x4*)(t.dst + (size_t)dn * t.K + t.k0 + kh + 8 * q) = w;
  }
}


DEV unsigned long long probe_begin(int k) { return (k == AMP_PHASE) ? __builtin_amdgcn_s_memrealtime() : 0ull; }
DEV void probe_end(int k, unsigned long long t0, const XcdBarrier& xb) {
  if (k == AMP_PHASE) {
    if (blockIdx.x == 0 && threadIdx.x == 0) { const unsigned long long t1 = __builtin_amdgcn_s_memrealtime(); while (__builtin_amdgcn_s_memrealtime() - t1 < (t1 - t0)) __builtin_amdgcn_s_sleep(4); }
    xcd_barrier(xb);
  }
}
__global__ void __launch_bounds__(512, 2) fwd_kernel(Params p) {
  __shared__ __attribute__((aligned(1024))) char shm[135168];
  __shared__ int s_unit;
  __shared__ float rowsc[1024];
  __shared__ __attribute__((aligned(16))) float halo[2048];
  __shared__ uint4 xb_words;
  cg::grid_group grid = cg::this_grid();
  if (threadIdx.x == 0) xb_words = make_uint4(0u, 0u, 0u, 0u);
  __syncthreads();
  unsigned* BAR = (unsigned*)(p.ws + OFF_CNT);
  const XcdBarrier xb = xcd_barrier_post(BAR, (volatile LDS_AS unsigned*)&xb_words);
  if (p.ws == nullptr) grid.sync();
  const int bid = blockIdx.x, nblk = gridDim.x;
  char* ws = p.ws;
  bf16_t* WIN = (bf16_t*)(ws + OFF_WIN); bf16_t* WUQ = (bf16_t*)(ws + OFF_WUQ); bf16_t* WUKV = (bf16_t*)(ws + OFF_WUKV); bf16_t* WO = (bf16_t*)(ws + OFF_WO);
  bf16_t* H = (bf16_t*)(ws + OFF_H); bf16_t* Y = (bf16_t*)(ws + OFF_Y); bf16_t* ACT = (bf16_t*)(ws + OFF_ACT); bf16_t* WUP = (bf16_t*)(ws + OFF_WUP);
  bf16_t* WDN = (bf16_t*)(ws + OFF_WDN); bf16_t* PROJ = (bf16_t*)(ws + OFF_PROJ); bf16_t* Q = (bf16_t*)(ws + OFF_Q);
  bf16_t* KV = (bf16_t*)(ws + OFF_KV); bf16_t* O = (bf16_t*)(ws + OFF_O); bf16_t* Y2 = (bf16_t*)(ws + OFF_Y2);
  float* COS = (float*)(ws + OFF_COS); float* SIN = (float*)(ws + OFF_SIN); float* STC = (float*)(ws + OFF_STC); float* STO = (float*)(ws + OFF_STO);
  float* STY = (float*)(ws + OFF_STY); float* STY2 = (float*)(ws + OFF_STY2); bf16_t* KR = (bf16_t*)(ws + OFF_KR); bf16_t* KSB = (bf16_t*)(ws + OFF_Y); bf16_t* VSB = KSB + (size_t)T_ * 1024; bf16_t* KM = KV; bf16_t* VM = KV + (size_t)T_ * 1024; float* HB = (float*)(ws + OFF_HB); unsigned* CNT = BAR + XB_QCNT;

  const unsigned long long pt0_ = probe_begin(0);
  PH(0) {
    const int tid = opaque_tid(), wid = tid >> 6, lane = tid & 63;
    {
      float* tile = (float*)shm;
      f32x4 v[8]; TrTile tt;
      int ti = bid;
      if (ti < 848) { tt = tr_decode(p, ws, ti); tr_load(tt, v, tid); }
    {
      const int tb = bid * 8 + wid;
      f32x4 xv[4][8]; float ss[4] = {0.f, 0.f, 0.f, 0.f};
#pragma unroll
      for (int q = 0; q < 4; ++q)
#pragma unroll
        for (int j = 0; j < 8; ++j) { xv[q][j] = __builtin_nontemporal_load((const f32x4*)(p.x + (size_t)(tb + q * 2048) * DM + j * 256 + lane * 4));
          ss[q] += (xv[q][j][0] * xv[q][j][0] + xv[q][j][1] * xv[q][j][1]) + (xv[q][j][2] * xv[q][j][2] + xv[q][j][3] * xv[q][j][3]); }
      float r[4];
#pragma unroll
      for (int q = 0; q < 4; ++q) r[q] = rsqrtf(wave_sum(ss[q]) * (1.f / 2048.f) + EPS);
#pragma unroll
      for (int j = 0; j < 8; ++j) { const f32x4 g4 = *(const f32x4*)(p.g_attn_pre + j * 256 + lane * 4);
#pragma unroll
        for (int q = 0; q < 4; ++q) { const f32x4 y = xv[q][j] * r[q] * g4;
          u32x2 w; w[0] = cvtpk(y[0], y[1]); w[1] = cvtpk(y[2], y[3]); *(u32x2*)(H + (size_t)(tb + q * 2048) * DM + j * 256 + lane * 4) = w; } }
    }
      for (; ti < 848; ti += nblk) {
        tr_to_lds(tt, v, tile, tid);
        __syncthreads();
        const TrTile cur = tt;
        if (ti + nblk < 848) { tt = tr_decode(p, ws, ti + nblk); tr_load(tt, v, tid); }
        tr_store(cur, tile, tid);
        __syncthreads();
      }
    }
    for (int idx = bid * 512 + tid; idx < T_ * 32; idx += nblk * 512) {
      const int t = idx >> 5, fi = idx & 31;
      const float inv = exp2f(-(float)fi * (13.287712379549449f / 32.f));
      const float ang = (float)p.pos[t] * inv;
      double rev = (double)ang * 0.15915494309189535; rev -= floor(rev);
      const float rf = (float)rev;
      COS[idx] = __builtin_amdgcn_cosf(rf); SIN[idx] = __builtin_amdgcn_sinf(rf);
    }
  }
  xcd_barrier(xb);
  probe_end(0, pt0_, xb);
  for (int es_ = 0; es_ < EXTRA_SYNC; ++es_) xcd_barrier(xb);
  const unsigned long long pt1_ = probe_begin(1);
  PH(1) { Epi<0> e; e.outK = KSB; e.outV = VSB; e.out = PROJ; e.ldo = INP; e.st_in = nullptr; e.st_out = STC;
    gemm_phase<0>(shm, rowsc, H, DM, WIN, 2048, 16, e); }
  xcd_barrier(xb);
  probe_end(1, pt1_, xb);
  const unsigned long long pt2_ = probe_begin(2);
  PH(2) {
    for (int idx = bid * 512 + opaque_tid(); idx < T_ * 32; idx += nblk * 512) {
      const int t = idx >> 5, i = idx & 31;
      const float x1 = __uint_as_float((unsigned)PROJ[(size_t)t * INP + 3840 + i] << 16), x2 = __uint_as_float((unsigned)PROJ[(size_t)t * INP + 3872 + i] << 16);
      const float c = COS[idx], sn = SIN[idx];
      KR[(size_t)t * 64 + i] = (bf16_t)(cvtpk(x1 * c - x2 * sn, 0.f) & 0xffffu); KR[(size_t)t * 64 + 32 + i] = (bf16_t)(cvtpk(x1 * sn + x2 * c, 0.f) & 0xffffu);
    }
    Epi<1> e; e.out = Q; e.ldo = 1536; e.st_in = STC; e.st_out = nullptr;
    gemm_phase<1>(shm, rowsc, PROJ + 3072, INP, WUQ, 512, 6, e);
    Epi<2> e2; e2.outK = KM; e2.outV = VM; e2.out = KV; e2.ldo = 2048; e2.st_in = STC; e2.st_out = nullptr;
    gemm_phase<2>(shm, rowsc, PROJ + 3584, INP, WUKV, 256, 8, e2); }
  xcd_barrier(xb);
  probe_end(2, pt2_, xb);
  const unsigned long long pt3_ = probe_begin(3);
  PH(3) for (int first_ = 1;; first_ = 0) {
    const int tid = opaque_tid();
    int u;
    if (first_) u = bid;
    else {
      if (tid == 0) s_unit = 256 + (int)atomicAdd(CNT, 1u);
      __syncthreads();
      u = s_unit;
      __syncthreads();
    }
    if (u >= 512 + 352) break;
    if (u >= 512) {
      float* tile = (float*)shm; f32x4 v[8]; TrTile tt;
      int ti = 848 + 4 * (u - 512); const int te = ti + 4;
      tt = tr_decode(p, ws, ti); tr_load(tt, v, tid);
      for (; ti < te; ++ti) {
        tr_to_lds(tt, v, tile, tid);
        __syncthreads();
        const TrTile cur = tt;
        if (ti + 1 < te) { tt = tr_decode(p, ws, ti + 1); tr_load(tt, v, tid); }
        tr_store(cur, tile, tid);
        __syncthreads();
      }
      continue;
    }
    const int mla = u < 256 ? 1 : 0, v_ = u & 255, qb = 7 - (v_ >> 5), b = (v_ & 31) >> 3, h = v_ & 7;
    const size_t r0 = (size_t)b * SEQ;
    if (mla) attn_unit<true>(shm, Q + r0 * 1536 + h * 192, 1536, KM + ((size_t)(b * 8 + h) * 2048) * 128, 128, KR + r0 * 64, 64, VM + ((size_t)(b * 8 + h) * 2048) * 128, 128,
                             O + r0 * 2048 + 1024 + h * 128, 2048, STO + r0 * 16 + 8 + h, qb, COS + r0 * 32, SIN + r0 * 32);
    else attn_unit<false>(shm, PROJ + r0 * INP + h * 128, INP, KSB + ((size_t)(b * 8 + h) * 2048) * 128, 128, nullptr, 0, VSB + ((size_t)(b * 8 + h) * 2048) * 128, 128,
                          O + r0 * 2048 + h * 128, 2048, STO + r0 * 16 + h, qb, nullptr, nullptr);
  }
  xcd_barrier(xb);
  probe_end(3, pt3_, xb);
  const unsigned long long pt4_ = probe_begin(4);
  PH(4) { Epi<3> e; e.out = Y; e.ldo = 2048; e.st_in = STO; e.st_out = STY;
    gemm_phase<3>(shm, rowsc, O, 2048, WO, 2048, 8, e); }
  xcd_barrier(xb);
  probe_end(4, pt4_, xb);
  const unsigned long long pt5_ = probe_begin(5);
  PH(5) for (int i = 0; i < 4; i += 2) {
    const int tid = opaque_tid(), wid = tid >> 6, lane = tid & 63;
    const int tb = bid * 8 + wid + i * 2048;
    float r[2]; f32x4 x1[2][4][2]; float ss[2];
#pragma unroll
    for (int q = 0; q < 2; ++q) {
      float s = STY[(size_t)(tb + q * 2048) * 32 + (lane & 31)];
      s += __shfl_xor(s, 16); s += __shfl_xor(s, 8); s += __shfl_xor(s, 4); s += __shfl_xor(s, 2); s += __shfl_xor(s, 1);
      r[q] = rsqrtf(s * (1.f / 2048.f) + EPS); ss[q] = 0.f;
    }
#pragma unroll
    for (int j = 0; j < 4; ++j) {
      const int c = j * 512 + lane * 8;
      const f32x4 ga = *(const f32x4*)(p.g_attn_post + c), gb = *(const f32x4*)(p.g_attn_post + c + 4);
#pragma unroll
      for (int q = 0; q < 2; ++q) {
        const size_t ro = (size_t)(tb + q * 2048) * DM + c;
        const u32x4 yw = __builtin_nontemporal_load((const u32x4*)(Y + ro));
        const f32x4 xa = __builtin_nontemporal_load((const f32x4*)(p.x + ro)), xb2 = __builtin_nontemporal_load((const f32x4*)(p.x + ro + 4));
        const f32x4 ya = {bf_lo(yw[0]), bf_hi(yw[0]), bf_lo(yw[1]), bf_hi(yw[1])}, yb = {bf_lo(yw[2]), bf_hi(yw[2]), bf_lo(yw[3]), bf_hi(yw[3])};
        x1[q][j][0] = xa + ya * r[q] * ga; x1[q][j][1] = xb2 + yb * r[q] * gb;
        { u32x4 xw; xw[0] = cvtpk(x1[q][j][0][0], x1[q][j][0][1]); xw[1] = cvtpk(x1[q][j][0][2], x1[q][j][0][3]); xw[2] = cvtpk(x1[q][j][1][0], x1[q][j][1][1]); xw[3] = cvtpk(x1[q][j][1][2], x1[q][j][1][3]);
          *(u32x4*)(Y + ro) = xw; }
#pragma unroll
        for (int h = 0; h < 2; ++h) ss[q] += (x1[q][j][h][0] * x1[q][j][h][0] + x1[q][j][h][1] * x1[q][j][h][1]) + (x1[q][j][h][2] * x1[q][j][h][2] + x1[q][j][h][3] * x1[q][j][h][3]);
      }
    }
    float r2[2];
#pragma unroll
    for (int q = 0; q < 2; ++q) r2[q] = rsqrtf(wave_sum(ss[q]) * (1.f / 2048.f) + EPS);
#pragma unroll
    for (int j = 0; j < 4; ++j) {
      const int c = j * 512 + lane * 8;
      const f32x4 ga = *(const f32x4*)(p.g_ffn_pre + c), gb = *(const f32x4*)(p.g_ffn_pre + c + 4);
#pragma unroll
      for (int q = 0; q < 2; ++q) {
        const f32x4 ha = x1[q][j][0] * r2[q] * ga, hb = x1[q][j][1] * r2[q] * gb;
        u32x4 w; w[0] = cvtpk(ha[0], ha[1]); w[1] = cvtpk(ha[2], ha[3]); w[2] = cvtpk(hb[0], hb[1]); w[3] = cvtpk(hb[2], hb[3]);
        *(u32x4*)(H + (size_t)(tb + q * 2048) * DM + c) = w;
      }
    }
  }
  xcd_barrier(xb);
  probe_end(5, pt5_, xb);
  const unsigned long long pt6_ = probe_begin(6);
  PH(6) { Epi<4> e; e.out = ACT; e.ldo = DFF; e.st_in = nullptr; e.st_out = nullptr;
    gemm_phase<4>(shm, rowsc, H, DM, WUP, 2048, 44, e, halo, HB, p.conv_w, p.conv_b);
    if (bid >= 128) {
      const int tid = opaque_tid(); float* tile = (float*)shm; f32x4 v[8]; TrTile tt;
      int ti = 2256 + (bid - 128);
      if (ti < 2960) { tt = tr_decode(p, ws, ti); tr_load(tt, v, tid); }
      for (; ti < 2960; ti += 128) {
        tr_to_lds(tt, v, tile, tid);
        __syncthreads();
        const TrTile cur = tt;
        if (ti + 128 < 2960) { tt = tr_decode(p, ws, ti + 128); tr_load(tt, v, tid); }
        tr_store(cur, tile, tid);
        __syncthreads();
      }
    } }
  xcd_barrier(xb);
  probe_end(6, pt6_, xb);
  const unsigned long long pt7_ = probe_begin(7);
  PH(7) for (int it = bid * 512 + opaque_tid(); it < 28 * 2 * 1408; it += nblk * 512) {
    const int c4 = it % 1408, rs = (it / 1408) & 1, pmi = it / 2816, pm = (pmi / 7) * 8 + (pmi % 7) + 1, ch = c4 * 4;
    const int colg = (ch >> 7) * 256 + (ch & 127), colv = colg + 128;
    const float* h0 = HB + (size_t)((pm - 1) * 4) * DFF2; const float* h1 = HB + (size_t)(pm * 4) * DFF2;
    const f32x4 gm2 = *(const f32x4*)(h0 + colg), gm1 = *(const f32x4*)(h0 + DFF2 + colg), g0 = *(const f32x4*)(h1 + 2 * DFF2 + colg), g1 = *(const f32x4*)(h1 + 3 * DFF2 + colg);
    const f32x4 vm2 = *(const f32x4*)(h0 + colv), vm1 = *(const f32x4*)(h0 + DFF2 + colv), v0 = *(const f32x4*)(h1 + 2 * DFF2 + colv), v1 = *(const f32x4*)(h1 + 3 * DFF2 + colv);
    const f32x4 cg = rs ? g1 : g0, pg1 = rs ? g0 : gm1, pg2 = rs ? gm1 : gm2, cv = rs ? v1 : v0, pv1 = rs ? v0 : vm1, pv2 = rs ? vm1 : vm2;
    const f32x4 wg0 = *(const f32x4*)(p.conv_w + ch), wg1 = *(const f32x4*)(p.conv_w + DFF2 + ch), wg2 = *(const f32x4*)(p.conv_w + 2 * DFF2 + ch), bg = *(const f32x4*)(p.conv_b + ch);
    const f32x4 wv0 = *(const f32x4*)(p.conv_w + DFF + ch), wv1 = *(const f32x4*)(p.conv_w + DFF2 + DFF + ch), wv2 = *(const f32x4*)(p.conv_w + 2 * DFF2 + DFF + ch), bv = *(const f32x4*)(p.conv_b + DFF + ch);
    const f32x4 ug = wg2 * cg + wg1 * pg1 + wg0 * pg2 + bg, uv = wv2 * cv + wv1 * pv1 + wv0 * pv2 + bv;
    u32x2 w; w[0] = cvtpk(gelu_tanh(ug[0]) * uv[0], gelu_tanh(ug[1]) * uv[1]); w[1] = cvtpk(gelu_tanh(ug[2]) * uv[2], gelu_tanh(ug[3]) * uv[3]);
    *(u32x2*)(ACT + (size_t)(pm * 256 + rs) * DFF + ch) = w;
  }
  xcd_barrier(xb);
  probe_end(7, pt7_, xb);
  const unsigned long long pt8_ = probe_begin(8);
  PH(8) { Epi<5> e; e.out = Y2; e.ldo = 2048; e.st_in = nullptr; e.st_out = STY2;
    gemm_phase<5>(shm, rowsc, ACT, DFF, WDN, DFF, 8, e); }
  xcd_barrier(xb);
  probe_end(8, pt8_, xb);
  const unsigned long long pt9_ = probe_begin(9);
  PH(9) {
    const int tid = opaque_tid(), wid = tid >> 6, lane = tid & 63;
    const int tb = bid * 8 + wid;
    float r[4];
#pragma unroll
    for (int q = 0; q < 4; ++q) {
      float s = STY2[(size_t)(tb + q * 2048) * 32 + (lane & 31)];
      s += __shfl_xor(s, 16); s += __shfl_xor(s, 8); s += __shfl_xor(s, 4); s += __shfl_xor(s, 2); s += __shfl_xor(s, 1);
      r[q] = rsqrtf(s * (1.f / 2048.f) + EPS);
    }
#pragma unroll
    for (int j = 0; j < 4; ++j) {
      const int c = j * 512 + lane * 8;
      const f32x4 ga = *(const f32x4*)(p.g_ffn_post + c), gb = *(const f32x4*)(p.g_ffn_post + c + 4);
#pragma unroll
      for (int q = 0; q < 4; ++q) {
        const size_t ro = (size_t)(tb + q * 2048) * DM + c;
        const u32x4 yw = __builtin_nontemporal_load((const u32x4*)(Y2 + ro));
        const u32x4 xw = __builtin_nontemporal_load((const u32x4*)(Y + ro));
        const f32x4 xa = {bf_lo(xw[0]), bf_hi(xw[0]), bf_lo(xw[1]), bf_hi(xw[1])}, xb2 = {bf_lo(xw[2]), bf_hi(xw[2]), bf_lo(xw[3]), bf_hi(xw[3])};
        const f32x4 ya = {bf_lo(yw[0]), bf_hi(yw[0]), bf_lo(yw[1]), bf_hi(yw[1])}, yb = {bf_lo(yw[2]), bf_hi(yw[2]), bf_lo(yw[3]), bf_hi(yw[3])};
        __builtin_nontemporal_store(xa + ya * r[q] * ga, (f32x4*)(p.out + ro)); __builtin_nontemporal_store(xb2 + yb * r[q] * gb, (f32x4*)(p.out + ro + 4));
      }
    }
  }
}

extern "C" void kernel_launch(void* const* d_in, const int* in_sizes, int n_in, void* d_out, int out_size, void* d_ws, size_t ws_size, hipStream_t stream) {
  if (n_in != 18 || ws_size < WS_END) { fprintf(stderr, "kernel_launch: unexpected n_in %d / ws_size %zu (need %zu)\n", n_in, ws_size, (size_t)WS_END); return; }
  static int grid_blocks = 0;
  if (!grid_blocks) {
    int dev = 0, cus = 0, per_cu = 0;
    (void)hipGetDevice(&dev);
    (void)hipDeviceGetAttribute(&cus, hipDeviceAttributeMultiprocessorCount, dev);
    (void)hipOccupancyMaxActiveBlocksPerMultiprocessor(&per_cu, fwd_kernel, 512, 0);
    if (per_cu < 1) per_cu = 1;
    grid_blocks = 256;
  }
  Params p{};
  p.x = (const float*)d_in[0]; p.pos = (const int*)d_in[1]; p.g_attn_pre = (const float*)d_in[2]; p.w_in = (const float*)d_in[3]; p.g_cq = (const float*)d_in[4];
  p.w_uq = (const float*)d_in[5]; p.g_ckv = (const float*)d_in[6]; p.w_ukv = (const float*)d_in[7]; p.g_out_sb = (const float*)d_in[8]; p.g_out_mla = (const float*)d_in[9];
  p.w_o = (const float*)d_in[10]; p.g_attn_post = (const float*)d_in[11]; p.g_ffn_pre = (const float*)d_in[12]; p.w_up = (const float*)d_in[13]; p.conv_w = (const float*)d_in[14];
  p.conv_b = (const float*)d_in[15]; p.w_down = (const float*)d_in[16]; p.g_ffn_post = (const float*)d_in[17]; p.out = (float*)d_out; p.ws = (char*)d_ws;
  (void)hipMemsetAsync((char*)d_ws + OFF_CNT, 0, 16384, stream);
  void* args[] = {&p};
  hipError_t e = hipLaunchCooperativeKernel((void*)fwd_kernel, dim3(grid_blocks), dim3(512), args, 0, stream);
  if (e != hipSuccess) fprintf(stderr, "cooperative launch failed: %s (grid %d)\n", hipGetErrorString(e), grid_blocks);
}
```
